# Optimizing an MI355X kernel written in HIP

```python
import jax, jax.numpy as jnp
from jax import lax
import numpy as np

D_MODEL = 1024
BATCH = 32
SEQ = 2048
DEPTH = 2

CTX_LEN = 256
GRID_W = 64
EPS = 1e-6

HEAD_DIM = 64
ATT_WIDTH = D_MODEL // 2
N_HEADS = ATT_WIDTH // HEAD_DIM
N_KV_HEADS = N_HEADS // 4
KV_WIDTH = N_KV_HEADS * HEAD_DIM
Q_BLOCK = 128
ROPE_BASE = 10000.0

CHUNK = 128
SGU_WIDTH = D_MODEL // 4
N_SGU_GROUPS = 4
SGU_GROUP_DIM = SGU_WIDTH // N_SGU_GROUPS

POOL_WINDOWS = (2, 4, 8, 16)
POOL_WIDTH = D_MODEL // 4
N_POOL_GROUPS = len(POOL_WINDOWS)
POOL_GROUP_DIM = POOL_WIDTH // N_POOL_GROUPS

MIX_WIDTH = ATT_WIDTH + SGU_WIDTH + POOL_WIDTH
Q_END = ATT_WIDTH
K_END = Q_END + KV_WIDTH
V_END = K_END + KV_WIDTH
U_END = V_END + SGU_WIDTH
SV_END = U_END + SGU_WIDTH
IN_WIDTH = SV_END + POOL_WIDTH

D_FF = 2816
CONV_WIDTH = 3

kernel_name = "hybrid_parallel_attn_sgu_pool_convffn"


def rmsnorm(x, g):
    xf = x.astype(jnp.float32)
    y = xf * lax.rsqrt(jnp.mean(xf * xf, axis=-1, keepdims=True) + EPS)
    return (y * g.astype(jnp.float32)).astype(x.dtype)


def modulate(h, shift, scale):
    return h * (1 + scale) + shift


def axial_rope_tables(n, dtype):
    rows = n // GRID_W
    row = jnp.repeat(jnp.arange(rows), GRID_W).astype(jnp.float32)
    col = jnp.tile(jnp.arange(GRID_W), rows).astype(jnp.float32)
    axis_dim = HEAD_DIM // 2
    inv = ROPE_BASE ** (-jnp.arange(0, axis_dim, 2, dtype=jnp.float32) / axis_dim)
    ang_r = row[:, None] * inv[None, :]
    ang_c = col[:, None] * inv[None, :]
    return (jnp.cos(ang_r).astype(dtype), jnp.sin(ang_r).astype(dtype),
            jnp.cos(ang_c).astype(dtype), jnp.sin(ang_c).astype(dtype))


def _rotate(xp, cos, sin):
    half = xp.shape[-1] // 2
    x1, x2 = xp[..., :half], xp[..., half:]
    c = cos[None, :, None, :]
    s = sin[None, :, None, :]
    return jnp.concatenate([x1 * c - x2 * s, x2 * c + x1 * s], axis=-1)


def apply_axial_rope(x, tabs):
    cos_r, sin_r, cos_c, sin_c = tabs
    axis_dim = HEAD_DIM // 2
    return jnp.concatenate([_rotate(x[..., :axis_dim], cos_r, sin_r),
                            _rotate(x[..., axis_dim:], cos_c, sin_c)], axis=-1)


def q_heads(p, q_gain):
    B, L, _ = p.shape
    q = p[..., :Q_END].reshape(B, L, N_HEADS, HEAD_DIM)
    return rmsnorm(q, q_gain)


def kv_heads(p, k_gain):
    B, L, _ = p.shape
    k = p[..., Q_END:K_END].reshape(B, L, N_KV_HEADS, HEAD_DIM)
    v = p[..., K_END:V_END].reshape(B, L, N_KV_HEADS, HEAD_DIM)
    return rmsnorm(k, k_gain), v


def _attend(qi, k, v):
    s = jnp.einsum('bqkgd,bnkd->bkgqn', qi, k, preferred_element_type=jnp.float32)
    pr = jax.nn.softmax(s, axis=-1).astype(v.dtype)
    return jnp.einsum('bkgqn,bnkd->bqkgd', pr, v)


def latent_attention(q, kx, vx, kc, vc):
    B, S, H, hd = q.shape
    G = H // N_KV_HEADS
    k = jnp.concatenate([kx, kc], axis=1)
    v = jnp.concatenate([vx, vc], axis=1)
    q = q * (hd ** -0.5)
    qb = q.reshape(B, S // Q_BLOCK, Q_BLOCK, N_KV_HEADS, G, hd).transpose(1, 0, 2, 3, 4, 5)
    o = lax.map(lambda qi: _attend(qi, k, v), qb)
    return o.transpose(1, 0, 2, 3, 4, 5).reshape(B, S, H * hd)


def context_attention(q, k, v):
    B, C, H, hd = q.shape
    G = H // N_KV_HEADS
    qg = (q * (hd ** -0.5)).reshape(B, C, N_KV_HEADS, G, hd)
    return _attend(qg, k, v).reshape(B, C, H * hd)


def spatial_gating(p, w_s, b_s):
    B, L, _ = p.shape
    u = p[..., V_END:U_END]
    v = p[..., U_END:SV_END].reshape(B, L // CHUNK, CHUNK, N_SGU_GROUPS, SGU_GROUP_DIM)
    mix = jnp.einsum('gpq,bnqgd->bnpgd', w_s, v) + b_s.T[None, None, :, :, None]
    return u * mix.reshape(B, L, SGU_WIDTH)


def multi_scale_pool(p, w_pool, pool_scale):
    B, L, _ = p.shape
    xp = p[..., SV_END:IN_WIDTH]
    outs = []
    for gi, w in enumerate(POOL_WINDOWS):
        xg = xp[..., gi * POOL_GROUP_DIM:(gi + 1) * POOL_GROUP_DIM].astype(jnp.float32)
        left = w // 2
        right = w - 1 - left
        cs = jnp.cumsum(jnp.pad(xg, ((0, 0), (left + 1, right), (0, 0))), axis=1)
        tot = cs[:, w:w + L] - cs[:, :L]
        t = np.arange(L)
        cnt = (np.minimum(t + right, L - 1) - np.maximum(t - left, 0) + 1).astype(np.float32)
        mean = tot / jnp.asarray(cnt)[None, :, None]
        outs.append((mean - xg).astype(p.dtype))
    y = jnp.stack(outs, axis=2)
    y = jnp.einsum('blgd,gde->blge', y, w_pool).reshape(B, L, POOL_WIDTH)
    return y * pool_scale


def conv_ffn(h, w_up, conv_w, conv_b, w_down):
    z = h @ w_up
    zp = jnp.pad(z, ((0, 0), (1, 1), (0, 0)))
    z = zp[:, :-2] * conv_w[0] + zp[:, 1:-1] * conv_w[1] + zp[:, 2:] * conv_w[2] + conv_b
    g, val = z[..., :D_FF], z[..., D_FF:]
    return (jax.nn.silu(g) * val) @ w_down


def setup_inputs(seed: int = 0) -> dict:
    key = jax.random.key(seed)
    ks = jax.random.split(key, 24)
    f32 = jnp.float32
    nrm = lambda k, shape, s: jax.random.normal(k, shape, f32) * s
    D = D_MODEL
    return {
        "x": nrm(ks[0], (BATCH, SEQ, D), 1.0),
        "c": nrm(ks[1], (BATCH, D), 1.0),
        "ctx": nrm(ks[2], (BATCH, CTX_LEN, D), 1.0),
        "c_ctx": nrm(ks[3], (D,), 1.0),
        "w_mod": nrm(ks[4], (DEPTH, D, 6 * D), 0.5 * D ** -0.5),
        "b_mod": nrm(ks[5], (DEPTH, 6 * D), 0.01),
        "norm1_g": 1.0 + nrm(ks[6], (DEPTH, D), 0.02),
        "w_in": nrm(ks[7], (DEPTH, D, IN_WIDTH), D ** -0.5),
        "q_gain": 1.0 + nrm(ks[8], (DEPTH, HEAD_DIM), 0.02),
        "k_gain": 1.0 + nrm(ks[9], (DEPTH, HEAD_DIM), 0.02),
        "w_s": nrm(ks[10], (DEPTH, N_SGU_GROUPS, CHUNK, CHUNK), CHUNK ** -0.5),
        "b_s": nrm(ks[11], (DEPTH, N_SGU_GROUPS, CHUNK), 0.01),
        "w_pool": nrm(ks[12], (DEPTH, N_POOL_GROUPS, POOL_GROUP_DIM, POOL_GROUP_DIM), POOL_GROUP_DIM ** -0.5),
        "pool_scale": 1.0 + nrm(ks[13], (DEPTH, POOL_WIDTH), 0.1),
        "w_out": nrm(ks[14], (DEPTH, MIX_WIDTH, D), MIX_WIDTH ** -0.5),
        "norm2_g": 1.0 + nrm(ks[15], (DEPTH, D), 0.02),
        "w_up": nrm(ks[16], (DEPTH, D, 2 * D_FF), D ** -0.5),
        "conv_w": nrm(ks[17], (DEPTH, CONV_WIDTH, 2 * D_FF), CONV_WIDTH ** -0.5),
        "conv_b": nrm(ks[18], (DEPTH, 2 * D_FF), 0.01),
        "w_down": nrm(ks[19], (DEPTH, D_FF, D), D_FF ** -0.5),
        "final_g": 1.0 + nrm(ks[20], (D,), 0.02),
    }


def reference(x, c, ctx, c_ctx, w_mod, b_mod, norm1_g, w_in, q_gain, k_gain, w_s, b_s,
              w_pool, pool_scale, w_out, norm2_g, w_up, conv_w, conv_b, w_down, final_g):
    tabs = axial_rope_tables(x.shape[1], x.dtype)
    silu_c = jax.nn.silu(c)
    silu_cc = jax.nn.silu(c_ctx)
    for i in range(DEPTH):
        last = i == DEPTH - 1
        mod_x = (silu_c @ w_mod[i] + b_mod[i])[:, None, :]
        mod_c = silu_cc @ w_mod[i] + b_mod[i]
        sh1, sc1, g1, sh2, sc2, g2 = jnp.split(mod_x, 6, axis=-1)
        csh1, csc1, cg1, csh2, csc2, cg2 = jnp.split(mod_c, 6, axis=-1)

        hx = modulate(rmsnorm(x, norm1_g[i]), sh1, sc1)
        hc = modulate(rmsnorm(ctx, norm1_g[i]), csh1, csc1)
        px = hx @ w_in[i]
        pc = hc @ w_in[i]

        qx = apply_axial_rope(q_heads(px, q_gain[i]), tabs)
        kx, vx = kv_heads(px, k_gain[i])
        kx = apply_axial_rope(kx, tabs)
        kc, vc = kv_heads(pc, k_gain[i])

        att_x = latent_attention(qx, kx, vx, kc, vc)
        sgu_x = spatial_gating(px, w_s[i], b_s[i])
        pool_x = multi_scale_pool(px, w_pool[i], pool_scale[i])
        mix_x = jnp.concatenate([att_x, sgu_x, pool_x], axis=-1) @ w_out[i]
        x = x + g1 * mix_x

        x = x + g2 * conv_ffn(modulate(rmsnorm(x, norm2_g[i]), sh2, sc2),
                              w_up[i], conv_w[i], conv_b[i], w_down[i])

        if not last:
            qc = q_heads(pc, q_gain[i])
            att_c = context_attention(qc, kc, vc)
            sgu_c = spatial_gating(pc, w_s[i], b_s[i])
            pool_c = multi_scale_pool(pc, w_pool[i], pool_scale[i])
            mix_c = jnp.concatenate([att_c, sgu_c, pool_c], axis=-1) @ w_out[i]
            ctx = ctx + cg1 * mix_c
            ctx = ctx + cg2 * conv_ffn(modulate(rmsnorm(ctx, norm2_g[i]), csh2, csc2),
                                       w_up[i], conv_w[i], conv_b[i], w_down[i])
    return rmsnorm(x, final_g)
```

```cpp
#include <hip/hip_runtime.h>
#include <hip/hip_cooperative_groups.h>
#include <hip/hip_bf16.h>
#include <cstdio>
#include <cstdint>
#include <cmath>
namespace cg = cooperative_groups;
namespace pg8 { __device__ __forceinline__ int opaque_tid() { int t = threadIdx.x; asm volatile("" : "+v"(t)); return t; } }
namespace pg8 {
#define PG8_LAS __attribute__((address_space(3)))
typedef unsigned short bf16_t;
typedef short bf16x8 __attribute__((ext_vector_type(8)));
typedef float f32x4 __attribute__((ext_vector_type(4)));
typedef unsigned u32x4 __attribute__((ext_vector_type(4)));
constexpr int BM = 256, BK = 64, HALF = 128, HTB = HALF * BK * 2  , STAGE_BYTES = 8 * HTB, NXCD = 8, WGM = 4;

__host__ __device__ __forceinline__ int lds_byte(int r, int c) { const int st = (r >> 4) * 2 + (c >> 5), rr = r & 15, cc = c & 31, ob = rr * 64 + cc * 2; return st * 1024 + (ob ^ (((ob >> 9) & 1) << 5)); }
__host__ __device__ __forceinline__ void stage_rc(int b, int& R, int& C) { const int st = b / 1024, sb = b % 1024, swz = sb ^ (((sb >> 9) & 1) << 5); R = (st >> 1) * 16 + swz / 64; C = (st & 1) * 32 + (swz % 64) / 2; }
__host__ __device__ __forceinline__ int perm32(int rho) { const int n = rho >> 4, i = rho & 15; return 8 * (i >> 2) + 4 * n + (i & 3); }

struct Unit { int pm, pn; };
struct Gemm { const bf16_t* A; const bf16_t* Bt; int M, N, K; };

struct StaticOrder {
    int nM, nN, nwg, G, c;
    __host__ __device__ void init(int M, int N, int G_, int c_) { nM = M / BM; nN = N / BM; nwg = nM * nN; G = G_; c = c_; }
    __host__ __device__ bool next(int i, Unit& u) const {
        const long L = (long)i * G + c; if (L >= nwg) return false;
        int wgid = (int)L; { const int q = nwg / NXCD, r = nwg % NXCD, xcd = wgid % NXCD, off = wgid / NXCD; wgid = (xcd < r ? xcd * (q + 1) : r * (q + 1) + (xcd - r) * q) + off; }
        const int nig = WGM * nN, gid = wgid / nig, fm = gid * WGM, gsz = (nM - fm) < WGM ? (nM - fm) : WGM;
        u.pm = fm + ((wgid % nig) % gsz); u.pn = (wgid % nig) / gsz; return true;
    }
    __device__ __forceinline__ void a_ready(const Unit&) const {}
    __device__ __forceinline__ void done(const Unit&) const {}
};

__device__ __forceinline__ unsigned cvt_pk_bf16(float lo, float hi) { unsigned r; asm volatile("v_cvt_pk_bf16_f32 %0, %1, %2" : "=v"(r) : "v"(lo), "v"(hi)); return r; }
typedef float f32x2 __attribute__((ext_vector_type(2)));
__device__ __forceinline__ f32x2 gelu_pk(f32x2 v) {
    const f32x2 av = __builtin_elementwise_abs(v), d = av * 0.2316418882f + 1.0f;
    f32x2 t; t.x = __builtin_amdgcn_rcpf(d.x); t.y = __builtin_amdgcn_rcpf(d.y);
    f32x2 q = t * 0.5307027145f + (-0.7265760135f); q = q * t + 0.7107068705f; q = q * t + (-0.142248368f); q = q * t + 0.127414796f; q = q * t;
    const f32x2 s = (v * v) * (-0.72134752044f);
    f32x2 e; e.x = __builtin_amdgcn_exp2f(s.x); e.y = __builtin_amdgcn_exp2f(s.y);
    const f32x2 m = v * (q * e), r = v - m;
    f32x2 o; o.x = v.x < 0.f ? m.x : r.x; o.y = v.y < 0.f ? m.y : r.y; return o;
}

template <int ACT  > struct EpiBf16 {
    static constexpr bool PERM = true, AFTER_DRAIN = false; static_assert(ACT == 0 || ACT == 1, "EpiBf16: ACT is 0 (none) or 1 (gelu_pk)");
    bf16_t* O; int ldc; const float* bias; int split_cols; size_t split_stride; float scale0;
    __device__ __forceinline__ void operator()(const f32x4 (&acc)[2][2][4][2], const Unit& u, int wr, int wc, int fr, int fq) const {
        const int row0 = u.pm * BM + wr * 64 + fr; int colt = u.pn * BM; bf16_t* base = O;
        float sc = 1.f; if (split_cols) { const int t = colt / split_cols; base += (size_t)t * split_stride; colt -= t * split_cols; if (t == 0) sc = scale0; }
        const int col0 = colt + wc * 32 + 8 * fq, bcol0 = u.pn * BM + wc * 32 + 8 * fq;
        f32x4 bv[2][2];
#pragma unroll
        for (int bj = 0; bj < 2; ++bj)
#pragma unroll
            for (int n = 0; n < 2; ++n) bv[bj][n] = bias ? *(const f32x4*)(bias + bcol0 + bj * HALF + 4 * n) : (f32x4){0.f, 0.f, 0.f, 0.f};
#pragma unroll
        for (int ai = 0; ai < 2; ++ai)
#pragma unroll
            for (int m = 0; m < 4; ++m) { bf16_t* rowp = base + (size_t)(row0 + ai * HALF + m * 16) * ldc + col0;
#pragma unroll
                for (int bj = 0; bj < 2; ++bj) { f32x4 v0 = acc[ai][bj][m][0] + bv[bj][0], v1 = acc[ai][bj][m][1] + bv[bj][1];
                    if (ACT == 1) { f32x2 a = gelu_pk((f32x2){v0[0], v0[1]}), b = gelu_pk((f32x2){v0[2], v0[3]}), c = gelu_pk((f32x2){v1[0], v1[1]}), d = gelu_pk((f32x2){v1[2], v1[3]});
                        v0 = (f32x4){a.x, a.y, b.x, b.y}; v1 = (f32x4){c.x, c.y, d.x, d.y}; }
                    v0 = v0 * sc; v1 = v1 * sc; u32x4 w; w.x = cvt_pk_bf16(v0[0], v0[1]); w.y = cvt_pk_bf16(v0[2], v0[3]); w.z = cvt_pk_bf16(v1[0], v1[1]); w.w = cvt_pk_bf16(v1[2], v1[3]);
                    *(u32x4*)(rowp + bj * HALF) = w; } }
    }
};
__device__ __forceinline__ unsigned cvtpk2(float lo, float hi) { typedef float f2 __attribute__((ext_vector_type(2))); typedef __bf16 b2 __attribute__((ext_vector_type(2))); f2 v = {lo, hi}; b2 b = __builtin_convertvector(v, b2); return __builtin_bit_cast(unsigned, b); }
template <int CTRL> __device__ __forceinline__ float dppz(float v) { return __builtin_bit_cast(float, __builtin_amdgcn_update_dpp(0, __builtin_bit_cast(int, v), CTRL, 0xf, 0xf, true)); }
template <int CTRL> __device__ __forceinline__ f32x4 dppz4(f32x4 v) { f32x4 r; r[0] = dppz<CTRL>(v[0]); r[1] = dppz<CTRL>(v[1]); r[2] = dppz<CTRL>(v[2]); r[3] = dppz<CTRL>(v[3]); return r; }
#ifdef V_NOSILU
__device__ __forceinline__ float silu_f(float x) { return x; }
#else
__device__ __forceinline__ float silu_f(float x) { return x * __builtin_amdgcn_rcpf(1.0f + __builtin_amdgcn_exp2f(-1.4426950408889634f * x)); }
#endif

struct EpiRes {
    static constexpr bool PERM = true, AFTER_DRAIN = false;
    const float* xin; const float* ctxin; bf16_t* X; const float* gate; int from_inputs;
    __device__ __forceinline__ void operator()(const f32x4 (&acc)[2][2][4][2], const Unit& u, int wr, int wc, int fr, int fq) const {
        const int b = u.pm / 9, j = u.pm - 9 * b, midx = (j == 8) ? 32 : b;
        bf16_t* xt = X + (size_t)u.pm * 256 * 1024;
        const int col0 = u.pn * BM + wc * 32 + 8 * fq;
        f32x4 gv[2][2];
#pragma unroll
        for (int bj = 0; bj < 2; ++bj)
#pragma unroll
            for (int n = 0; n < 2; ++n) gv[bj][n] = *(const f32x4*)(gate + (size_t)midx * 6144 + col0 + bj * HALF + n * 4);
        if (from_inputs) {
            const float* basef = (j < 8 ? xin + (size_t)(b * 2048 + 256 * j) * 1024 : ctxin + (size_t)b * 256 * 1024);
#pragma unroll
            for (int ai = 0; ai < 2; ++ai) {
                f32x4 fb[4][2][2];
#pragma unroll
                for (int m = 0; m < 4; ++m)
#pragma unroll
                    for (int bj = 0; bj < 2; ++bj) { const float* p = basef + (unsigned)((ai * HALF + wr * 64 + m * 16 + fr) * 1024 + col0) + bj * HALF; fb[m][bj][0] = *(const f32x4*)p; fb[m][bj][1] = *(const f32x4*)(p + 4); }
                asm volatile("" ::: "memory");
#pragma unroll
                for (int m = 0; m < 4; ++m) { const unsigned off = (unsigned)((ai * HALF + wr * 64 + m * 16 + fr) * 1024 + col0);
#pragma unroll
                    for (int bj = 0; bj < 2; ++bj) {
                        const f32x4 o0 = fb[m][bj][0] + gv[bj][0] * acc[ai][bj][m][0], o1 = fb[m][bj][1] + gv[bj][1] * acc[ai][bj][m][1];
                        u32x4 w; w.x = cvtpk2(o0[0], o0[1]); w.y = cvtpk2(o0[2], o0[3]); w.z = cvtpk2(o1[0], o1[1]); w.w = cvtpk2(o1[2], o1[3]);
                        *(u32x4*)(xt + off + bj * HALF) = w; } }
                asm volatile("" ::: "memory");
            }
        } else {
            u32x4 rb[2][4][2];
#pragma unroll
            for (int ai = 0; ai < 2; ++ai)
#pragma unroll
                for (int m = 0; m < 4; ++m)
#pragma unroll
                    for (int bj = 0; bj < 2; ++bj) rb[ai][m][bj] = *(const u32x4*)(xt + (unsigned)((ai * HALF + wr * 64 + m * 16 + fr) * 1024 + col0) + bj * HALF);
            asm volatile("" ::: "memory");
#pragma unroll
            for (int ai = 0; ai < 2; ++ai)
#pragma unroll
                for (int m = 0; m < 4; ++m) { const unsigned off = (unsigned)((ai * HALF + wr * 64 + m * 16 + fr) * 1024 + col0);
#pragma unroll
                    for (int bj = 0; bj < 2; ++bj) { const u32x4 r = rb[ai][m][bj];
                        const f32x4 b0 = (f32x4){__uint_as_float(r.x << 16), __uint_as_float(r.x & 0xffff0000u), __uint_as_float(r.y << 16), __uint_as_float(r.y & 0xffff0000u)};
                        const f32x4 b1 = (f32x4){__uint_as_float(r.z << 16), __uint_as_float(r.z & 0xffff0000u), __uint_as_float(r.w << 16), __uint_as_float(r.w & 0xffff0000u)};
                        const f32x4 o0 = b0 + gv[bj][0] * acc[ai][bj][m][0], o1 = b1 + gv[bj][1] * acc[ai][bj][m][1];
                        u32x4 w; w.x = cvtpk2(o0[0], o0[1]); w.y = cvtpk2(o0[2], o0[3]); w.z = cvtpk2(o1[0], o1[1]); w.w = cvtpk2(o1[2], o1[3]);
                        *(u32x4*)(xt + off + bj * HALF) = w; } }
        }
    }
};

struct EpiUpGate {
    static constexpr bool PERM = true, AFTER_DRAIN = false;
    bf16_t* A; float* SB; const float* cw; const float* cb; PG8_LAS float* cl  ;
    __device__ __forceinline__ void operator()(const f32x4 (&acc)[2][2][4][2], const Unit& u, int wr, int wc, int fr, int fq) const {
        const int jc = u.pn * 128 + wc * 32 + 8 * fq;
        PG8_LAS float* cwv = cl + (wr * 4 + wc) * 256;
        { const int v = fr + 16 * fq, hv = v >> 5, k = (v >> 3) & 3, c4 = v & 7;
          const float* src = (k < 3 ? cw + k * 5632 : cb) + hv * 2816 + u.pn * 128 + wc * 32 + 4 * c4;
          *(PG8_LAS f32x4*)(cwv + v * 4) = *(const f32x4*)src;
          asm volatile("s_waitcnt lgkmcnt(0)" ::: "memory"); }
#define CWL(hv_, k_, n_) (*(const PG8_LAS f32x4*)(cwv + ((hv_) * 4 + (k_)) * 32 + 8 * fq + 4 * (n_)))
#if 1
#pragma unroll
        for (int n = 0; n < 2; ++n) {
            const int j0 = jc + 4 * n;
            const f32x4 w0g = CWL(0, 0, n), w1g = CWL(0, 1, n), w2g = CWL(0, 2, n), bg = CWL(0, 3, n);
            const f32x4 w0v = CWL(1, 0, n), w1v = CWL(1, 1, n), w2v = CWL(1, 2, n), bv = CWL(1, 3, n);
#pragma unroll
            for (int ai = 0; ai < 2; ++ai) {
                float* sb = SB + ((size_t)(u.pm * 8 + 2 * (2 * ai + wr)) * 4) * 2816 + j0;
                { const f32x4 zg = acc[ai][0][0][n], zv = acc[ai][1][0][n];
                  const f32x4 cgv = w1g * zg + w2g * dppz4<0x101>(zg) + bg, cvv = w1v * zv + w2v * dppz4<0x101>(zv) + bv;
                  if (fr == 0) { *(f32x4*)(sb) = zg; *(f32x4*)(sb + 2816) = zv; *(f32x4*)(sb + 2 * 2816) = cgv; *(f32x4*)(sb + 3 * 2816) = cvv; } }
                { const f32x4 zg = acc[ai][0][3][n], zv = acc[ai][1][3][n];
                  const f32x4 cgv = w1g * zg + w0g * dppz4<0x111>(zg) + bg, cvv = w1v * zv + w0v * dppz4<0x111>(zv) + bv;
                  if (fr == 15) { float* sb1 = sb + 4 * 2816; *(f32x4*)(sb1) = zg; *(f32x4*)(sb1 + 2816) = zv; *(f32x4*)(sb1 + 2 * 2816) = cgv; *(f32x4*)(sb1 + 3 * 2816) = cvv; } }
                asm volatile("" ::: "memory"); __builtin_amdgcn_sched_barrier(0);
            }
        }
#endif
        unsigned pk[2][4][2];
#pragma unroll
        for (int n = 0; n < 2; ++n) {
            const int j0 = jc + 4 * n;
            const f32x4 w0g = CWL(0, 0, n), w1g = CWL(0, 1, n), w2g = CWL(0, 2, n), bg = CWL(0, 3, n);
            const f32x4 w0v = CWL(1, 0, n), w1v = CWL(1, 1, n), w2v = CWL(1, 2, n), bv = CWL(1, 3, n);
#pragma unroll
            for (int ai = 0; ai < 2; ++ai) {
#pragma unroll
                for (int m = 0; m < 4; ++m) {
                    const f32x4 zg = acc[ai][0][m][n], zv = acc[ai][1][m][n];
#ifdef V_NODPP
                    f32x4 pg = zg, pv = zv, ng = zg, nv = zv;
#else
                    f32x4 pg = dppz4<0x111>(zg), pv = dppz4<0x111>(zv), ng = dppz4<0x101>(zg), nv = dppz4<0x101>(zv);
                    if (m > 0) { pg += dppz4<0x10F>(acc[ai][0][m - 1][n]); pv += dppz4<0x10F>(acc[ai][1][m - 1][n]); }
                    if (m < 3) { ng += dppz4<0x11F>(acc[ai][0][m + 1][n]); nv += dppz4<0x11F>(acc[ai][1][m + 1][n]); }
#endif
                    const f32x4 cgv = w1g * zg + w0g * pg + w2g * ng + bg, cvv = w1v * zv + w0v * pv + w2v * nv + bv;
                    const int rho = 2 * ai + wr;
#if 0
                    if ((m == 0 && fr == 0) || (m == 3 && fr == 15)) {
                        float* sb = SB + ((size_t)(u.pm * 8 + 2 * rho + (m == 3 ? 1 : 0)) * 4) * 2816 + j0;
                        *(f32x4*)(sb) = zg; *(f32x4*)(sb + 2816) = zv; *(f32x4*)(sb + 2 * 2816) = cgv; *(f32x4*)(sb + 3 * 2816) = cvv;
                    }
#endif
                    const unsigned lo = cvtpk2(silu_f(cgv[0]) * cvv[0], silu_f(cgv[1]) * cvv[1]), hi = cvtpk2(silu_f(cgv[2]) * cvv[2], silu_f(cgv[3]) * cvv[3]);
                    if (n == 0) { pk[ai][m][0] = lo; pk[ai][m][1] = hi; }
                    else { u32x4 w; w.x = pk[ai][m][0]; w.y = pk[ai][m][1]; w.z = lo; w.w = hi;
                        *(u32x4*)(A + (size_t)(u.pm * BM + ai * HALF + wr * 64 + m * 16 + fr) * 2816 + jc) = w; }
                    if (m & 1) { asm volatile("" ::: "memory"); __builtin_amdgcn_sched_barrier(0); }
                }
            }
        }
    }
};
#undef CWL

struct TileOrder {
    int nM, nN, nwg, G, c, skip;
    __device__ void init(int nM_, int N, int G_, int c_, int skip_) { nM = nM_; nN = N / BM; nwg = nM * nN; G = G_; c = c_; skip = skip_; }
    __device__ bool next(int i, Unit& u) const {
        const long L = (long)i * G + c; if (L >= nwg) return false;
        int wgid = (int)L; { const int q = nwg / NXCD, r = nwg % NXCD, xcd = wgid % NXCD, off = wgid / NXCD; wgid = (xcd < r ? xcd * (q + 1) : r * (q + 1) + (xcd - r) * q) + off; }
        const int nig = WGM * nN, gid = wgid / nig, fm = gid * WGM, gsz = (nM - fm) < WGM ? (nM - fm) : WGM;
        int pm = fm + ((wgid % nig) % gsz); u.pn = (wgid % nig) / gsz;
        if (skip) pm = (pm >> 3) * 9 + (pm & 7);
        u.pm = pm; return true;
    }
    __device__ __forceinline__ void a_ready(const Unit&) const {}
    __device__ __forceinline__ void done(const Unit&) const {}
};
template <class Epi, class Sched, bool ALIGN_EPI = false, bool SP2 = false>
__device__ __forceinline__ void gemm_phase(PG8_LAS unsigned char* lds, const Gemm g, const Sched& S, const Epi& E) {
    const int tid = opaque_tid(), wid = __builtin_amdgcn_readfirstlane(tid >> 6), lane = tid & 63, wr = wid >> 2, wc = wid & 3, fr = lane & 15, fq = lane >> 4;
    const int K = g.K, nt = K / BK;
    unsigned voffA[2], voffB[2];
#pragma unroll
    for (int i = 0; i < 2; ++i) { int R, C; stage_rc(tid * 16 + i * 8192, R, C); const int Rb = Epi::PERM ? ((R & ~31) + perm32(R & 31)) : R;
        voffA[i] = (unsigned)(R * K + C) * 2u; voffB[i] = (unsigned)(Rb * K + C) * 2u; }
    const size_t kstep = (size_t)(BK * 2);
    const size_t hstep = (size_t)HALF * K * 2;
    const size_t tstep = 2 * hstep;
    const unsigned ldsw = (unsigned)wid * 1024u;
    const int aoff = lds_byte(wr * 64 + fr, fq * 8), boff = lds_byte(wc * 32 + fr, fq * 8);
#define PG8_SA(b, h) (((b) * 2 + (h)) * HTB)
#define PG8_SB(b, h) ((4 + (b) * 2 + (h)) * HTB)
#define PG8_STAGE(bufoff, gbase, voff) do { _Pragma("unroll") for (int _i = 0; _i < 2; ++_i) \
        __builtin_amdgcn_global_load_lds((const unsigned*)((const char*)(gbase) + (voff)[_i]), (PG8_LAS unsigned*)(lds + (bufoff) + ldsw + _i * 8192), 16, 0, 0); } while (0)
#define PG8_LDA(dst, b, h) do { _Pragma("unroll") for (int m = 0; m < 4; ++m) _Pragma("unroll") for (int k = 0; k < 2; ++k) dst[m][k] = *(const PG8_LAS bf16x8*)(lds + PG8_SA(b, h) + aoff + m * 2048 + k * 1024); } while (0)
#define PG8_LDB(dst, b, h) do { _Pragma("unroll") for (int n = 0; n < 2; ++n) _Pragma("unroll") for (int k = 0; k < 2; ++k) dst[n][k] = *(const PG8_LAS bf16x8*)(lds + PG8_SB(b, h) + boff + n * 2048 + k * 1024); } while (0)
#define PG8_MMA(ai, bj, At, Bt) do { __builtin_amdgcn_s_setprio(1); _Pragma("unroll") for (int m = 0; m < 4; ++m) _Pragma("unroll") for (int n = 0; n < 2; ++n) _Pragma("unroll") for (int k = 0; k < 2; ++k) \
        acc[ai][bj][m][n] = __builtin_amdgcn_mfma_f32_16x16x32_bf16(Bt[n][k], At[m][k], acc[ai][bj][m][n], 0, 0, 0); __builtin_amdgcn_s_setprio(0); } while (0)
#define PG8_WAIT_V(n) asm volatile("s_waitcnt vmcnt(" #n ")" ::: "memory")
#define PG8_WAIT_L(n) asm volatile("s_waitcnt lgkmcnt(" #n ")" ::: "memory")
#define PG8_BAR __builtin_amdgcn_s_barrier()
#define PG8_SCHED __builtin_amdgcn_sched_barrier(0)
    Unit cur, nxt; int ui = 0;
    if (!S.next(0, cur)) return;
    f32x4 acc[2][2][4][2];
#pragma unroll
    for (int a = 0; a < 2; ++a)
#pragma unroll
        for (int b = 0; b < 2; ++b)
#pragma unroll
            for (int m = 0; m < 4; ++m)
#pragma unroll
                for (int n = 0; n < 2; ++n) acc[a][b][m][n] = (f32x4){0.f, 0.f, 0.f, 0.f};
    bf16x8 At[4][2], B0[2][2], B1[2][2];
    const char* cA = (const char*)g.A + (size_t)cur.pm * tstep; const char* cB = (const char*)g.Bt + (size_t)cur.pn * tstep;
    S.a_ready(cur);
    if constexpr (SP2) {
        PG8_STAGE(PG8_SB(0, 0), cB, voffB); PG8_STAGE(PG8_SB(0, 1), cB + hstep, voffB); PG8_STAGE(PG8_SA(0, 0), cA, voffA); PG8_STAGE(PG8_SA(0, 1), cA + hstep, voffA);
        if (wr == 1) PG8_BAR;
        PG8_WAIT_V(2); PG8_BAR;
        PG8_STAGE(PG8_SB(1, 0), cB + kstep, voffB); PG8_STAGE(PG8_SA(1, 0), cA + kstep, voffA); PG8_STAGE(PG8_SB(1, 1), cB + hstep + kstep, voffB);
        PG8_WAIT_V(6); PG8_BAR;
    } else {
        PG8_STAGE(PG8_SB(0, 0), cB, voffB); PG8_STAGE(PG8_SA(0, 0), cA, voffA); PG8_STAGE(PG8_SB(0, 1), cB + hstep, voffB); PG8_STAGE(PG8_SA(0, 1), cA + hstep, voffA);
        if (wr == 1) PG8_BAR;
        PG8_WAIT_V(4); PG8_BAR;
        PG8_STAGE(PG8_SB(1, 0), cB + kstep, voffB); PG8_STAGE(PG8_SA(1, 0), cA + kstep, voffA); PG8_STAGE(PG8_SB(1, 1), cB + hstep + kstep, voffB);
        PG8_WAIT_V(6); PG8_BAR;
    }
    for (;;) {
        const bool has_next = S.next(ui + 1, nxt);
        const char* nA = has_next ? (const char*)g.A + (size_t)nxt.pm * tstep : cA; const char* nB = has_next ? (const char*)g.Bt + (size_t)nxt.pn * tstep : cB;
        for (int t = 0; t < nt; t += 2) {
            const bool last = (t == nt - 2);
            const char* a1 = cA + (size_t)(t + 1) * kstep;
            const char* a2 = last ? nA : cA + (size_t)(t + 2) * kstep; const char* b2 = last ? nB : cB + (size_t)(t + 2) * kstep;
            const char* a3 = a2 + kstep; const char* b3 = b2 + kstep;
            if (last && has_next) S.a_ready(nxt);
            if constexpr (SP2) {
            PG8_LDB(B0, 0, 0); PG8_LDB(B1, 0, 1); PG8_SCHED; PG8_LDA(At, 0, 0); PG8_STAGE(PG8_SA(1, 1), a1 + hstep, voffA);
            PG8_WAIT_V(8); PG8_WAIT_L(0); PG8_BAR; PG8_MMA(0, 0, At, B0); PG8_MMA(0, 1, At, B1); PG8_BAR; PG8_SCHED;
            PG8_LDA(At, 0, 1); PG8_STAGE(PG8_SB(0, 0), b2, voffB); PG8_STAGE(PG8_SB(0, 1), b2 + hstep, voffB); PG8_STAGE(PG8_SA(0, 0), a2, voffA);
            PG8_WAIT_V(8); PG8_WAIT_L(0); PG8_BAR; PG8_MMA(1, 0, At, B0); PG8_MMA(1, 1, At, B1); PG8_BAR; PG8_SCHED;
            PG8_LDB(B0, 1, 0); PG8_LDB(B1, 1, 1); PG8_SCHED; PG8_LDA(At, 1, 0); PG8_STAGE(PG8_SA(0, 1), a2 + hstep, voffA);
            PG8_WAIT_V(8); PG8_WAIT_L(0); PG8_BAR; PG8_MMA(0, 0, At, B0); PG8_MMA(0, 1, At, B1); PG8_BAR; PG8_SCHED;
            PG8_LDA(At, 1, 1); PG8_STAGE(PG8_SB(1, 0), b3, voffB); PG8_STAGE(PG8_SB(1, 1), b3 + hstep, voffB); PG8_STAGE(PG8_SA(1, 0), a3, voffA);
            PG8_WAIT_V(8); PG8_WAIT_L(0); PG8_BAR; PG8_MMA(1, 0, At, B0); PG8_MMA(1, 1, At, B1); PG8_BAR; PG8_SCHED;
            } else {
            PG8_LDB(B0, 0, 0); PG8_SCHED; PG8_LDA(At, 0, 0); PG8_STAGE(PG8_SA(1, 1), a1 + hstep, voffA);
            PG8_WAIT_L(8); PG8_BAR; PG8_WAIT_L(0); PG8_MMA(0, 0, At, B0); PG8_BAR; PG8_SCHED;
            PG8_LDB(B1, 0, 1); PG8_STAGE(PG8_SB(0, 0), b2, voffB);
            PG8_BAR; PG8_WAIT_L(0); PG8_MMA(0, 1, At, B1); PG8_BAR;
            PG8_LDA(At, 0, 1); PG8_STAGE(PG8_SA(0, 0), a2, voffA);
            PG8_BAR; PG8_WAIT_L(0); PG8_MMA(1, 0, At, B0); PG8_BAR; PG8_SCHED;
            PG8_STAGE(PG8_SB(0, 1), b2 + hstep, voffB);
            PG8_WAIT_V(6); PG8_BAR; PG8_MMA(1, 1, At, B1); PG8_BAR;
            PG8_LDB(B0, 1, 0); PG8_SCHED; PG8_LDA(At, 1, 0); PG8_STAGE(PG8_SA(0, 1), a2 + hstep, voffA);
            PG8_WAIT_L(8); PG8_BAR; PG8_WAIT_L(0); PG8_MMA(0, 0, At, B0); PG8_BAR; PG8_SCHED;
            PG8_LDB(B1, 1, 1); PG8_STAGE(PG8_SB(1, 0), b3, voffB);
            PG8_BAR; PG8_WAIT_L(0); PG8_MMA(0, 1, At, B1); PG8_BAR;
            PG8_LDA(At, 1, 1); PG8_STAGE(PG8_SA(1, 0), a3, voffA);
            PG8_BAR; PG8_WAIT_L(0); PG8_MMA(1, 0, At, B0); PG8_BAR; PG8_SCHED;
            PG8_STAGE(PG8_SB(1, 1), b3 + hstep, voffB);
            PG8_WAIT_V(6); PG8_BAR; PG8_MMA(1, 1, At, B1); PG8_BAR;
            }
        }
        if constexpr (ALIGN_EPI) { if (wr == 0) PG8_BAR; }
        if constexpr (!Epi::AFTER_DRAIN) { E(acc, cur, wr, wc, fr, fq); S.done(cur); }
        if (!has_next) break;
#pragma unroll
        for (int a = 0; a < 2; ++a)
#pragma unroll
            for (int b = 0; b < 2; ++b)
#pragma unroll
                for (int m = 0; m < 4; ++m)
#pragma unroll
                    for (int n = 0; n < 2; ++n) acc[a][b][m][n] = (f32x4){0.f, 0.f, 0.f, 0.f};
        cur = nxt; cA = nA; cB = nB; ++ui;
        if constexpr (ALIGN_EPI) { if (wr == 1) PG8_BAR; }
    }
    PG8_WAIT_V(0);
    if constexpr (!ALIGN_EPI) { if (wr == 0) PG8_BAR; }
    PG8_BAR;
    if constexpr (Epi::AFTER_DRAIN) { E.fused(acc, cur, wr, wc, fr, fq, lds, wid, lane); S.done(cur); }
#undef PG8_SA
#undef PG8_SB
#undef PG8_STAGE
#undef PG8_LDA
#undef PG8_LDB
#undef PG8_MMA
#undef PG8_WAIT_V
#undef PG8_WAIT_L
#undef PG8_BAR
#undef PG8_SCHED
}
}

#include <hip/hip_bf16.h>
#include <cmath>
namespace attn_body {
using bf16=__hip_bfloat16;
using bf16x8=__attribute__((ext_vector_type(8)))short;
using s16x4=__attribute__((ext_vector_type(4)))short;
using f32x16=__attribute__((ext_vector_type(16)))float;
using u32x4=__attribute__((ext_vector_type(4)))unsigned;
constexpr int D=64,PK=1536,PO=1024;
constexpr int NW=8,QBLK=32,QB=QBLK*NW,KVBLK=64;
constexpr int ATTN_UNIT_ROWS=QB;
__device__ __forceinline__ int crow(int r,int hi){return (r&3)+8*(r>>2)+4*hi;}
#define SBAR() __builtin_amdgcn_sched_barrier(0)
__device__ __forceinline__ void cmask(f32x16&p0,f32x16&p1,int jb,int qrel,int hi){
  const float NEG=-INFINITY; int kb=64*jb+4*hi;
  #pragma unroll
  for(int r=0;r<16;++r){int kv=kb+(r&3)+8*(r>>2); if(kv>qrel)p0[r]=NEG; if(kv+32>qrel)p1[r]=NEG;}
}

constexpr int NSLOT=3, SLOTB=8192;
constexpr int LDS_K=0, LDS_V=NSLOT*SLOTB, LDS_WS=2*NSLOT*SLOTB, LDS_OST=LDS_WS+NW*64*4, LDS_BYTES=LDS_OST+NW*4096;
constexpr float C2=0.125f*1.4426950408889634f;
__device__ __forceinline__ void glds16(const void*gsrc,unsigned lds_dst){unsigned keep;
  asm volatile("s_mov_b32 %0, m0\n\ts_mov_b32 m0, %2\n\ts_nop 0\n\tglobal_load_lds_dwordx4 %1, off\n\ts_mov_b32 m0, %0":"=&s"(keep):"v"(gsrc),"s"(lds_dst):"memory");}
__device__ __forceinline__ float max3f(float a,float b,float c){float r;asm("v_max3_f32 %0, %1, %2, %3":"=v"(r):"v"(a),"v"(b),"v"(c));return r;}
__device__ __forceinline__ float max2f(float a,float b){float r;asm("v_max_f32_e32 %0, %1, %2":"=v"(r):"v"(a),"v"(b));return r;}
__device__ __forceinline__ float fadd_s(float a,float b){float r;asm("v_add_f32_e32 %0, %1, %2":"=v"(r):"v"(a),"v"(b));return r;}
__device__ __forceinline__ float fsub_s(float a,float b){float r;asm("v_sub_f32_e32 %0, %1, %2":"=v"(r):"v"(a),"v"(b));return r;}
typedef float f32x2_t __attribute__((ext_vector_type(2))); typedef __bf16 bf16x2_t __attribute__((ext_vector_type(2)));
__device__ __forceinline__ unsigned cvtpk_s(float lo,float hi){f32x2_t v={lo,hi};bf16x2_t b=__builtin_convertvector(v,bf16x2_t);return __builtin_bit_cast(unsigned,b);}
#define WAIT_BAR(N) asm volatile("s_waitcnt vmcnt(" #N ") lgkmcnt(0)\n\ts_barrier":::"memory")

__device__ __forceinline__ void qkt(f32x16&p0,f32x16&p1,const char*Kslot,const bf16x8*qr,const f32x16&negm,int r32,int hi){
  const char*kb=Kslot+hi*1024+r32*16;
  #pragma unroll
  for(int d0=0;d0<4;++d0){
    const bf16x8 b0=*reinterpret_cast<const bf16x8*>(kb+d0*2048);
    const bf16x8 b1=*reinterpret_cast<const bf16x8*>(kb+d0*2048+512);
    if(d0==0){p0=__builtin_amdgcn_mfma_f32_32x32x16_bf16(b0,qr[0],negm,0,0,0);p1=__builtin_amdgcn_mfma_f32_32x32x16_bf16(b1,qr[0],negm,0,0,0);}
    else{p0=__builtin_amdgcn_mfma_f32_32x32x16_bf16(b0,qr[d0],p0,0,0,0);p1=__builtin_amdgcn_mfma_f32_32x32x16_bf16(b1,qr[d0],p1,0,0,0);}}
}
typedef __attribute__((address_space(3))) const char* lds_cptr;
typedef short v4i16_t __attribute__((ext_vector_type(4)));
__device__ __forceinline__ void kload8(bf16x8*kf,lds_cptr kp){
  kf[0]=*(const __attribute__((address_space(3))) bf16x8*)(kp);      kf[1]=*(const __attribute__((address_space(3))) bf16x8*)(kp+512);
  kf[2]=*(const __attribute__((address_space(3))) bf16x8*)(kp+2048); kf[3]=*(const __attribute__((address_space(3))) bf16x8*)(kp+2560);
  kf[4]=*(const __attribute__((address_space(3))) bf16x8*)(kp+4096); kf[5]=*(const __attribute__((address_space(3))) bf16x8*)(kp+4608);
  kf[6]=*(const __attribute__((address_space(3))) bf16x8*)(kp+6144); kf[7]=*(const __attribute__((address_space(3))) bf16x8*)(kp+6656);
}
__device__ __forceinline__ void kload2(bf16x8*kf,lds_cptr kp,int j){ kf[2*j]=*(const __attribute__((address_space(3))) bf16x8*)(kp+j*2048); kf[2*j+1]=*(const __attribute__((address_space(3))) bf16x8*)(kp+j*2048+512); }
__device__ __forceinline__ s16x4 vtr(lds_cptr p){ return __builtin_bit_cast(s16x4,__builtin_amdgcn_ds_read_tr16_b64_v4i16((__attribute__((address_space(3))) v4i16_t*)p)); }
__device__ __forceinline__ float rowmax(const f32x16&p0,const f32x16&p1){
  float a=max3f(p0[0],p0[1],p1[0]),b=max3f(p0[2],p0[3],p1[1]);a=max3f(a,p1[2],p1[3]);
  #pragma unroll
  for(int r=4;r<16;r+=4){a=max3f(a,p0[r],p0[r+1]);b=max3f(b,p0[r+2],p0[r+3]);a=max3f(a,p1[r],p1[r+1]);b=max3f(b,p1[r+2],p1[r+3]);}
  const float m=max2f(a,b);
  auto rr=__builtin_amdgcn_permlane32_swap(__float_as_uint(m),__float_as_uint(m),false,false);
  return max2f(__uint_as_float(rr[0]),__uint_as_float(rr[1]));
}
__device__ __forceinline__ void pv(f32x16*o,int vb,bf16x8 pa0,bf16x8 pa1,bf16x8 pa2,bf16x8 pa3){
  #pragma unroll
  for(int d0=0;d0<2;++d0){s16x4 lo[4],hi[4];
    #pragma unroll
    for(int ks=0;ks<4;++ks){
      asm volatile("ds_read_b64_tr_b16 %0,%1 offset:%c2":"=&v"(lo[ks]):"v"(vb),"i"(d0*4096+ks*1024):"memory");
      asm volatile("ds_read_b64_tr_b16 %0,%1 offset:%c2":"=&v"(hi[ks]):"v"(vb),"i"(d0*4096+ks*1024+512):"memory");}
    asm volatile("s_waitcnt lgkmcnt(0)":::"memory");SBAR();
    #define PK(k) (bf16x8){lo[k][0],lo[k][1],lo[k][2],lo[k][3],hi[k][0],hi[k][1],hi[k][2],hi[k][3]}
    o[d0]=__builtin_amdgcn_mfma_f32_32x32x16_bf16(pa0,PK(0),o[d0],0,0,0);
    o[d0]=__builtin_amdgcn_mfma_f32_32x32x16_bf16(pa1,PK(1),o[d0],0,0,0);
    o[d0]=__builtin_amdgcn_mfma_f32_32x32x16_bf16(pa2,PK(2),o[d0],0,0,0);
    o[d0]=__builtin_amdgcn_mfma_f32_32x32x16_bf16(pa3,PK(3),o[d0],0,0,0);
    #undef PK
  }
}

#ifndef ATTN_STORE16
#define ATTN_STORE16(p,v) (*(u32x4*)(p)=(v))
#endif
template<int THRL> __device__ __forceinline__ void attn_unit(const bf16*Qu,const bf16*__restrict__ Kh,const bf16*__restrict__ Vh,bf16*Ou,const int NT,char*shm,const float*qgain,const int t0){
  const int tid=pg8::opaque_tid(),lane=tid&63,r32=lane&31,hi=lane>>5; const int wid=__builtin_amdgcn_readfirstlane(tid>>6);
  const bf16*Qw=Qu+(long)(wid*QBLK)*PK;
  const unsigned lds0=(unsigned)(uintptr_t)shm;
  float*wsf=(float*)(shm+LDS_WS)+wid*64;
  const bf16*ksrc=Kh+(long)lane*PK+wid*8;
  const bf16*vsrc=Vh+(long)(16*(wid&3)+(lane>>2))*PK+(wid>>2)*32+(lane&3)*8;
  const unsigned kdst=lds0+LDS_K+wid*1024, vdst=lds0+LDS_V+wid*1024;
  #define DMA_K(t,slot) glds16(ksrc+(long)(t)*KVBLK*PK,(unsigned)__builtin_amdgcn_readfirstlane(kdst+(slot)))
  #define DMA_V(t,slot) glds16(vsrc+(long)(t)*KVBLK*PK,(unsigned)__builtin_amdgcn_readfirstlane(vdst+(slot)))
  const int vb0=(int)(lds0+LDS_V)+((lane>>4)&1)*32+(lane&3)*8+(4*hi+((lane&15)>>2))*64;
  const char*Kbase=shm+LDS_K; bf16x8 kf[8];
  const lds_cptr shm3=(lds_cptr)shm; const lds_cptr kp0=shm3+LDS_K+hi*1024+r32*16; const lds_cptr vp0=shm3+LDS_V+((lane>>4)&1)*32+(lane&3)*8+(4*hi+((lane&15)>>2))*64;
  DMA_K(0,0);DMA_V(0,0);DMA_K(1,SLOTB);
  bf16x8 qr[4];
  #pragma unroll
  for(int d0=0;d0<4;++d0)qr[d0]=*reinterpret_cast<const bf16x8*>(&Qw[(long)r32*PK+d0*16+hi*8]);
  {
    float qv[4][8];
    #pragma unroll
    for(int d0=0;d0<4;++d0){const u32x4 w=__builtin_bit_cast(u32x4,qr[d0]);
      qv[d0][0]=__uint_as_float(w.x<<16);qv[d0][1]=__uint_as_float(w.x&0xffff0000u);qv[d0][2]=__uint_as_float(w.y<<16);qv[d0][3]=__uint_as_float(w.y&0xffff0000u);
      qv[d0][4]=__uint_as_float(w.z<<16);qv[d0][5]=__uint_as_float(w.z&0xffff0000u);qv[d0][6]=__uint_as_float(w.w<<16);qv[d0][7]=__uint_as_float(w.w&0xffff0000u);}
    float ss=0.f;
    #pragma unroll
    for(int d0=0;d0<4;++d0){
      #pragma unroll
      for(int i=0;i<8;++i)ss+=qv[d0][i]*qv[d0][i];}
    {auto rr=__builtin_amdgcn_permlane32_swap(__float_as_uint(ss),__float_as_uint(ss),false,false);ss=__uint_as_float(rr[0])+__uint_as_float(rr[1]);}
    const float rstd=1.0f/sqrtf(ss*(1.0f/64.0f)+1e-6f);
    #pragma unroll
    for(int d0=0;d0<4;++d0){
      #pragma unroll
      for(int i=0;i<8;++i)qv[d0][i]=qv[d0][i]*rstd*qgain[d0*16+hi*8+i];}
    if(t0>=0){const int tq=t0+wid*QBLK+r32;const float rp=(float)(tq>>6),cp=(float)(tq&63);
      #pragma unroll
      for(int i=0;i<8;++i){const float inv=exp2f(-(float)(hi*8+i)*(13.287712379549449f/16.0f));
        {const float a=rp*inv,c=__cosf(a),s=__sinf(a),x1=qv[0][i],x2=qv[1][i];qv[0][i]=x1*c-x2*s;qv[1][i]=x2*c+x1*s;}
        {const float a=cp*inv,c=__cosf(a),s=__sinf(a),x1=qv[2][i],x2=qv[3][i];qv[2][i]=x1*c-x2*s;qv[3][i]=x2*c+x1*s;}}}
    #pragma unroll
    for(int d0=0;d0<4;++d0){u32x4 w;w.x=cvtpk_s(qv[d0][0]*C2,qv[d0][1]*C2);w.y=cvtpk_s(qv[d0][2]*C2,qv[d0][3]*C2);w.z=cvtpk_s(qv[d0][4]*C2,qv[d0][5]*C2);w.w=cvtpk_s(qv[d0][6]*C2,qv[d0][7]*C2);qr[d0]=__builtin_bit_cast(bf16x8,w);}
  }
  float mhat=0.f,l_reg=0.f;f32x16 o[2];o[0]=f32x16{};o[1]=f32x16{};f32x16 negm=f32x16{};asm volatile("":"+v"(negm));
  #define CMASK(P0,P1,t) do{}while(0)
  bool resc=false;
  #define START(P0,P1) do{ const float rm=rowmax(P0,P1); resc=false; \
    { const float dl=rm; mhat=fadd_s(mhat,dl); \
      _Pragma("unroll") for(int r=0;r<16;++r){P0[r]=fsub_s(P0[r],dl);P1[r]=fsub_s(P1[r],dl);} \
      _Pragma("unroll") for(int r=0;r<16;++r)negm[r]=-mhat; asm volatile("":"+v"(negm)); } \
    _Pragma("unroll") for(int r=0;r<16;++r)P0[r]=__builtin_amdgcn_exp2f(P0[r]); }while(0)
  #define RESC() do{ if(resc){ asm volatile("s_waitcnt lgkmcnt(0)":::"memory"); \
      _Pragma("unroll") for(int d_=0;d_<2;++d_) _Pragma("unroll") for(int r=0;r<16;++r)o[d_][r]*=wsf[crow(r,hi)]; } }while(0)
  f32x16 pA0,pA1,pB0,pB1;
  int sl_prev=0,sl_cur=0,sl_next=SLOTB;
  #define ROT() do{sl_prev=sl_cur;sl_cur=sl_next;sl_next=(sl_next==(NSLOT-1)*SLOTB)?0:sl_next+SLOTB;}while(0)
  DMA_K(2,2*SLOTB);
  WAIT_BAR(3);
  qkt(pA0,pA1,Kbase,qr,negm,r32,hi);asm volatile("s_nop 15\n\ts_nop 7":"+v"(pA0),"+v"(pA1));CMASK(pA0,pA1,0);
  START(pA0,pA1);
  _Pragma("unroll") for(int r=0;r<16;++r)pA1[r]=__builtin_amdgcn_exp2f(pA1[r]);
  WAIT_BAR(0);
  DMA_K(3,0);DMA_V(1,SLOTB);
  ROT();
  kload8(kf,kp0+sl_cur);
  WAIT_BAR(2);
  s16x4 vlo[8],vhi[8]; u32x4 pw0,pw1,pw2,pw3;
  #define PKW(P,B) cvtpk_s(P[B],P[B+1])
  #define PAF(k) __builtin_bit_cast(bf16x8,pw##k)
  #define VFR(i) (bf16x8){vlo[i][0],vlo[i][1],vlo[i][2],vlo[i][3],vhi[i][0],vhi[i][1],vhi[i][2],vhi[i][3]}
  #define PIN(x) asm volatile("":"+v"(x))
  #define MX3(a,b,c) __builtin_fmaxf(__builtin_fmaxf((a),(b)),(c))
  #define GAPA(MF,A0,A1,A2,A3,W0,W1,PW) do{ MF; sacc+=A0; sacc+=A1; sacc+=A2; sacc+=A3; PIN(sacc); W0; W1; PIN(PW); SBAR(); }while(0)
  #define EX(v) __builtin_amdgcn_exp2f(v)
  #define GAPB(MF,X,B) do{ MF; X[B]=EX(X[B]); X[B+1]=EX(X[B+1]); X[B+2]=EX(X[B+2]); X[B+3]=EX(X[B+3]); PIN(X); SBAR(); }while(0)
  #define VRD(i) do{ vlo[i]=vtr(vp_+(((i)>>2)*4096+((i)&3)*1024)); vhi[i]=vtr(vp_+(((i)>>2)*4096+((i)&3)*1024+512)); }while(0)
  #define KRD(G,j) do{ if(G){ kload2(kf,kp0+sl_next,j); SBAR(); } }while(0)
  #define STEP(C0,C1,P0,P1,t,GK,GV,GL) do{ SBAR(); \
    const lds_cptr vp_=vp0+sl_prev; \
    VRD(0); SBAR(); float sacc=(P0[0]+P0[1]); \
    GAPA(C0=__builtin_amdgcn_mfma_f32_32x32x16_bf16(kf[0],qr[0],negm,0,0,0), P0[2],P0[3],P0[4],P0[5],     pw0[0]=PKW(P0,0), pw0[1]=PKW(P0,2), pw0); \
    VRD(4); SBAR(); GAPA(C1=__builtin_amdgcn_mfma_f32_32x32x16_bf16(kf[1],qr[0],negm,0,0,0), P0[6],P0[7],P0[8],P0[9],     pw0[2]=PKW(P0,4), pw0[3]=PKW(P0,6), pw0); \
    VRD(1); SBAR(); GAPA(C0=__builtin_amdgcn_mfma_f32_32x32x16_bf16(kf[2],qr[1],C0,0,0,0),   P0[10],P0[11],P0[12],P0[13], pw1[0]=PKW(P0,8), pw1[1]=PKW(P0,10), pw1); \
    VRD(5); SBAR(); GAPA(C1=__builtin_amdgcn_mfma_f32_32x32x16_bf16(kf[3],qr[1],C1,0,0,0),   P0[14],P0[15],P1[0],P1[1],   pw1[2]=PKW(P0,12),pw1[3]=PKW(P0,14), pw1); \
    VRD(2); SBAR(); GAPA(C0=__builtin_amdgcn_mfma_f32_32x32x16_bf16(kf[4],qr[2],C0,0,0,0),   P1[2],P1[3],P1[4],P1[5],     pw2[0]=PKW(P1,0), pw2[1]=PKW(P1,2), pw2); \
    VRD(6); SBAR(); GAPA(C1=__builtin_amdgcn_mfma_f32_32x32x16_bf16(kf[5],qr[2],C1,0,0,0),   P1[6],P1[7],P1[8],P1[9],     pw2[2]=PKW(P1,4), pw2[3]=PKW(P1,6), pw2); \
    VRD(3); SBAR(); GAPA(C0=__builtin_amdgcn_mfma_f32_32x32x16_bf16(kf[6],qr[3],C0,0,0,0),   P1[10],P1[11],P1[12],P1[13], pw3[0]=PKW(P1,8), pw3[1]=PKW(P1,10), pw3); \
    VRD(7); SBAR(); GAPA(C1=__builtin_amdgcn_mfma_f32_32x32x16_bf16(kf[7],qr[3],C1,0,0,0),   P1[14],P1[15],0.f,0.f,       pw3[2]=PKW(P1,12),pw3[3]=PKW(P1,14), pw3); \
    l_reg+=sacc; \
    if(GK){DMA_K((t)+3,sl_cur);} if(GV){DMA_V((t)+1,sl_next);} \
    CMASK(C0,C1,t); \
    { float a=MX3(C0[0],C0[1],C1[0]),b=MX3(C0[2],C0[3],C1[1]); a=MX3(a,C1[2],C1[3]); \
      _Pragma("unroll") for(int r=4;r<16;r+=4){a=MX3(a,C0[r],C0[r+1]);b=MX3(b,C0[r+2],C0[r+3]);a=MX3(a,C1[r],C1[r+1]);b=MX3(b,C1[r+2],C1[r+3]);} \
      float rm=__builtin_fmaxf(a,b); { auto rr=__builtin_amdgcn_permlane32_swap(__float_as_uint(rm),__float_as_uint(rm),false,false); rm=__builtin_fmaxf(__uint_as_float(rr[0]),__uint_as_float(rr[1])); } \
      resc=false; \
      if(__builtin_expect(__any(rm>(float)THRL),0)){ const float dl=__builtin_fmaxf(rm,0.f); mhat+=dl; \
        _Pragma("unroll") for(int r=0;r<16;++r){C0[r]-=dl;C1[r]-=dl;} \
        _Pragma("unroll") for(int r=0;r<16;++r)negm[r]=-mhat; asm volatile("":"+v"(negm)); \
        const float f=__builtin_amdgcn_exp2f(-dl); l_reg*=f; if(hi==0)wsf[r32]=f; resc=true; } } \
    SBAR(); \
    GAPB(o[0]=__builtin_amdgcn_mfma_f32_32x32x16_bf16(PAF(0),VFR(0),o[0],0,0,0), C0,0); \
    GAPB(o[1]=__builtin_amdgcn_mfma_f32_32x32x16_bf16(PAF(0),VFR(4),o[1],0,0,0), C0,4); \
    KRD(GL,0); GAPB(o[0]=__builtin_amdgcn_mfma_f32_32x32x16_bf16(PAF(1),VFR(1),o[0],0,0,0), C0,8); \
    KRD(GL,1); GAPB(o[1]=__builtin_amdgcn_mfma_f32_32x32x16_bf16(PAF(1),VFR(5),o[1],0,0,0), C0,12); \
    KRD(GL,2); GAPB(o[0]=__builtin_amdgcn_mfma_f32_32x32x16_bf16(PAF(2),VFR(2),o[0],0,0,0), C1,0); \
    KRD(GL,3); GAPB(o[1]=__builtin_amdgcn_mfma_f32_32x32x16_bf16(PAF(2),VFR(6),o[1],0,0,0), C1,4); \
    GAPB(o[0]=__builtin_amdgcn_mfma_f32_32x32x16_bf16(PAF(3),VFR(3),o[0],0,0,0), C1,8); \
    GAPB(o[1]=__builtin_amdgcn_mfma_f32_32x32x16_bf16(PAF(3),VFR(7),o[1],0,0,0), C1,12); \
    }while(0)
  int t=1;
  for(;t+5<NT;t+=2){
    STEP(pB0,pB1,pA0,pA1,t,true,true,true);     WAIT_BAR(2); RESC(); ROT();
    STEP(pA0,pA1,pB0,pB1,t+1,true,true,true);   WAIT_BAR(2); RESC(); ROT();
  }
  #define ENDW(tt) do{ if((tt)+3<NT){WAIT_BAR(2);} else if((tt)+2<NT){WAIT_BAR(1);} else {WAIT_BAR(0);} }while(0)
  for(;t+1<NT;t+=2){
    STEP(pB0,pB1,pA0,pA1,t,(t+3<NT),(t+1<NT),(t+1<NT));       ENDW(t);   RESC(); ROT();
    STEP(pA0,pA1,pB0,pB1,t+1,(t+4<NT),(t+2<NT),(t+2<NT));     ENDW(t+1); RESC(); ROT();
  }
  STEP(pB0,pB1,pA0,pA1,NT-1,false,false,false); RESC();
  { float sacc=pB0[0]+pB0[1]; _Pragma("unroll") for(int r=2;r<16;++r)sacc+=pB0[r]; _Pragma("unroll") for(int r=0;r<16;++r)sacc+=pB1[r]; l_reg+=sacc;
    pw0=(u32x4){PKW(pB0,0),PKW(pB0,2),PKW(pB0,4),PKW(pB0,6)};pw1=(u32x4){PKW(pB0,8),PKW(pB0,10),PKW(pB0,12),PKW(pB0,14)};pw2=(u32x4){PKW(pB1,0),PKW(pB1,2),PKW(pB1,4),PKW(pB1,6)};pw3=(u32x4){PKW(pB1,8),PKW(pB1,10),PKW(pB1,12),PKW(pB1,14)};
    SBAR(); pv(o,vb0+sl_cur,PAF(0),PAF(1),PAF(2),PAF(3)); }
  #undef PKW
  #undef PAF
  #undef VFR
  #undef PIN
  #undef MX3
  #undef GAPA
  #undef GAPB
  #undef EX
  #undef VRD
  #undef KRD
  #undef STEP
  #undef ENDW
  {auto rr=__builtin_amdgcn_permlane32_swap(__float_as_uint(l_reg),__float_as_uint(l_reg),false,false);l_reg=__uint_as_float(rr[0])+__uint_as_float(rr[1]);}
  if(hi==0)wsf[32+r32]=l_reg;asm volatile("s_waitcnt lgkmcnt(0)":::"memory");
  float rli[16];
  #pragma unroll
  for(int r=0;r<16;++r)rli[r]=__builtin_amdgcn_rcpf(wsf[32+crow(r,hi)]);
  bf16*Ow=Ou+(long)(wid*QBLK)*PO;
  { bf16*stg=(bf16*)(shm+LDS_OST)+wid*2048;
    #pragma unroll
    for(int r=0;r<16;++r){const int orow=crow(r,hi);
      #pragma unroll
      for(int d0=0;d0<2;++d0)stg[orow*64+d0*32+r32]=__float2bfloat16(o[d0][r]*rli[r]);}
    asm volatile("s_waitcnt lgkmcnt(0)":::"memory");
    #pragma unroll
    for(int i=0;i<4;++i){const int row=i*8+(lane>>3),ch=lane&7; const u32x4 v=*(const u32x4*)(stg+row*64+ch*8); ATTN_STORE16(Ow+(long)row*PO+ch*8,v);} }
  asm volatile("s_waitcnt lgkmcnt(0)\n\ts_barrier":::"memory");
  #undef DMA_K
  #undef DMA_V
  #undef CMASK
  #undef START
  #undef RESC
  #undef ROT
}
constexpr int ATTN_LDS_BYTES=LDS_BYTES;
#undef SBAR
#undef WAIT_BAR
}
constexpr int NB = 32, SEQ = 2048, CTXL = 256, TPB = SEQ + CTXL, MTOK = NB * TPB, DM = 1024, INW = 1536, FF = 2816, FF2 = 5632, MODW = 6144, NLAYER = 2;
constexpr int NTILE = MTOK / 256;
constexpr float EPS = 1e-6f;
constexpr size_t MiB = 1u << 20;
constexpr size_t WS_BAR = 0;
constexpr size_t WS_MOD = 1 * MiB;
constexpr size_t WS_WSB = 3 * MiB;
constexpr size_t WS_WPT = 3 * MiB + 512 * 1024;
constexpr size_t WS_PRM = 3 * MiB + 768 * 1024;
constexpr int PRM_N1G = 0, PRM_N2G = 1024, PRM_QG = 2048, PRM_KG = 2112, PRM_BS = 2176, PRM_PSC = 2688, PRM_CW = 2944, PRM_CB = PRM_CW + 3 * 5632, PRM_L = PRM_CB + 5632;
constexpr size_t WS_WIN = 4 * MiB, WS_WOUT = 10 * MiB, WS_WUP = 14 * MiB, WS_WDN = 36 * MiB;
constexpr size_t WS_SB = 48 * MiB;
constexpr size_t WS_X = 148 * MiB;
constexpr size_t WS_H = 436 * MiB;
constexpr size_t WS_P = 580 * MiB;
constexpr size_t WS_MIX = 796 * MiB;
constexpr size_t WS_A = 580 * MiB;
constexpr size_t WS_END = 976 * MiB;
static_assert(WS_SB + (size_t)NTILE * 8 * 4 * 2816 * 4 <= WS_X && WS_X + (size_t)MTOK * 1024 * 4 <= WS_H && WS_H + (size_t)MTOK * 1024 * 2 <= WS_P && WS_P + (size_t)MTOK * 1536 * 2 <= WS_MIX && WS_MIX + (size_t)MTOK * 1024 * 2 <= WS_END && WS_A + (size_t)MTOK * 2816 * 2 <= WS_END, "d_ws map");
static_assert(WS_WDN + 2 * (size_t)1024 * 2816 * 2 <= WS_SB && WS_WUP + 2 * (size_t)5632 * 1024 * 2 <= WS_WDN && WS_WOUT + 2 * (size_t)1024 * 1024 * 2 <= WS_WUP && WS_WIN + 2 * (size_t)1536 * 1024 * 2 <= WS_WOUT, "weights map");
constexpr int LDS_BYTES = 147456;

#define LAS __attribute__((address_space(3)))
typedef unsigned short bf16;
typedef unsigned v4u __attribute__((ext_vector_type(4)));
typedef unsigned v2u __attribute__((ext_vector_type(2)));
typedef float f32x4 __attribute__((ext_vector_type(4)));
typedef short bf16x8 __attribute__((ext_vector_type(8)));
#define LDS_WAIT() asm volatile("s_waitcnt lgkmcnt(0)" ::: "memory")
__device__ __forceinline__ unsigned pk2(float lo, float hi) { return pg8::cvtpk2(lo, hi); }
__device__ __forceinline__ float bflo(unsigned u) { return __uint_as_float(u << 16); }
__device__ __forceinline__ float bfhi(unsigned u) { return __uint_as_float(u & 0xffff0000u); }
__device__ __forceinline__ float wave_sum(float v) {
#pragma unroll
    for (int o = 1; o < 64; o <<= 1) v += __shfl_xor(v, o);
    return v;
}

__device__ __forceinline__ void p0_transpose_item(const float* W, int K, int N, bf16* WT, bool upperm, LAS float* scr, int item, int lane) {
    const int nblk = N / 32, kb = item / nblk, nb = item % nblk, k0 = 64 * kb, n0 = 32 * nb;
#pragma unroll 8
    for (int i = 0; i < 32; ++i) { const int kk = 2 * i + (lane >> 5); scr[kk * 33 + (lane & 31)] = W[(size_t)(k0 + kk) * N + n0 + (lane & 31)]; }
    LDS_WAIT(); asm volatile("" ::: "memory");
    int r0 = n0;
    if (upperm) { const int j = (n0 < FF) ? n0 : n0 - FF; r0 = 256 * (j >> 7) + (j & 127) + ((n0 < FF) ? 0 : 128); }
    const int c = lane & 7;
#pragma unroll
    for (int j = 0; j < 4; ++j) { const int n = (lane >> 3) + 8 * j; const LAS float* s = scr + (8 * c) * 33 + n;
        v4u o; o.x = pk2(s[0 * 33], s[1 * 33]); o.y = pk2(s[2 * 33], s[3 * 33]); o.z = pk2(s[4 * 33], s[5 * 33]); o.w = pk2(s[6 * 33], s[7 * 33]);
        *(v4u*)(WT + (size_t)(r0 + n) * K + k0 + 8 * c) = o; }
    LDS_WAIT(); asm volatile("" ::: "memory");
}

#define XB_TMO      128
#define XB_XCNT(j)  (256  + 64 * (j))
#define XB_XSUB(j)  (1280 + 64 * (j))
#define XB_XGEN(j)  (2304 + 64 * (j))
#define XB_TOP      3328
#define XB_TOPGEN   3392
#define XCD_BAR_WORDS 3456
#define XB_SPIN_CAP (1u << 18)

__device__ __forceinline__ unsigned xb_ld(unsigned* p)              { return __hip_atomic_load(p, __ATOMIC_RELAXED, __HIP_MEMORY_SCOPE_AGENT); }
__device__ __forceinline__ unsigned xb_add(unsigned* p, unsigned v) { return __hip_atomic_fetch_add(p, v, __ATOMIC_RELAXED, __HIP_MEMORY_SCOPE_AGENT); }
__device__ __forceinline__ unsigned xb_xcc_id() { return (unsigned)__builtin_amdgcn_s_getreg((3 << 11) | 20) & 0xFu; }
#define XB_SPIN(cond, bar) do { unsigned _sp = 0; while (cond) { __builtin_amdgcn_s_sleep(1); \
    if ((++_sp & 255u) == 0u) { if (xb_ld(&(bar)[XB_TMO])) break; if (_sp > XB_SPIN_CAP) { atomicAdd(&(bar)[XB_TMO], 1u); break; } } } } while (0)

struct XcdBarrier {
    unsigned* bar; unsigned x;
    volatile LAS unsigned* st;
};

__device__ __forceinline__ XcdBarrier xcd_barrier_post(unsigned* bar, volatile LAS unsigned* st) {
    XcdBarrier b; b.bar = bar; b.x = xb_xcc_id(); b.st = st;
    if (threadIdx.x == 0) (void)xb_add(&bar[XB_XCNT(b.x)], 1u);
    return b;
}
__device__ __forceinline__ void xcd_barrier_complete(unsigned* bar, unsigned x, unsigned& nloc, unsigned& nx) {
    const unsigned G = gridDim.x * gridDim.y * gridDim.z;
    unsigned sum, cnt, mine, sp = 0u;
    for (;;) {
        sum = 0u; cnt = 0u; mine = 0u;
#pragma unroll
        for (unsigned j = 0; j < 16; ++j) { const unsigned c = xb_ld(&bar[XB_XCNT(j)]); sum += c; cnt += (c > 0u) ? 1u : 0u; mine = (j == x) ? c : mine; }
        if (sum == G) break;
        __builtin_amdgcn_s_sleep(1);
        if ((++sp & 255u) == 0u) { if (xb_ld(&bar[XB_TMO])) break; if (sp > XB_SPIN_CAP) { atomicAdd(&bar[XB_TMO], 1u); break; } }
    }
    nloc = mine > 0u ? mine : 1u; nx = cnt > 0u ? cnt : 1u;
}

__device__ __forceinline__ void xcd_barrier(const XcdBarrier& b) {
    asm volatile("s_waitcnt vmcnt(0)" ::: "memory");
    __syncthreads();
    if (threadIdx.x == 0) {
        unsigned* bar = b.bar;
        __builtin_amdgcn_s_waitcnt(0);
        unsigned nloc = b.st[0], nx = b.st[1];
        if (nloc == 0u) { xcd_barrier_complete(bar, b.x, nloc, nx); b.st[0] = nloc; b.st[1] = nx; }
        const unsigned old = xb_add(&bar[XB_XSUB(b.x)], 1u);
        const unsigned gen = old / nloc;
        if (old + 1u == (gen + 1u) * nloc) {
            __builtin_amdgcn_fence(__ATOMIC_RELEASE, "agent");
            asm volatile("s_waitcnt vmcnt(0)" ::: "memory");
            const unsigned og = xb_add(&bar[XB_TOP], 1u);
            const unsigned tg = og / nx;
            if (og + 1u == (tg + 1u) * nx) xb_add(&bar[XB_TOPGEN], 1u);
            else XB_SPIN(xb_ld(&bar[XB_TOPGEN]) == tg, bar);
            __builtin_amdgcn_fence(__ATOMIC_ACQUIRE, "agent");
            xb_add(&bar[XB_XGEN(b.x)], 1u);
            asm volatile("s_waitcnt vmcnt(0)" ::: "memory");
        } else {
            XB_SPIN(xb_ld(&bar[XB_TOPGEN]) == gen, bar);
            __builtin_amdgcn_fence(__ATOMIC_ACQUIRE, "agent");
            asm volatile("s_waitcnt vmcnt(0)" ::: "memory");
        }
    }
    __syncthreads();
}

struct Args { const float* in[21]; float* out; unsigned char* ws; };

__device__ __forceinline__ void mod_phase(const Args& a, LAS unsigned char* lds, int tid) {
    LAS float* S = (LAS float*)lds;
    LAS float* OUT = (LAS float*)(lds + 33 * 1024 * 4);
    const float* c = a.in[1]; const float* cc = a.in[3]; const float* wmod = a.in[4]; const float* bmod = a.in[5];
    float* MOD = (float*)(a.ws + WS_MOD);
    for (int i = tid; i < 33 * 1024; i += 512) { const int m = i >> 10, k = i & 1023; const float v = (m < 32) ? c[m * 1024 + k] : cc[k]; S[i] = v / (1.0f + __expf(-v)); }
    __syncthreads();
    for (int u = blockIdx.x; u < 384; u += gridDim.x) {
        const int l = u / 192, col0 = (u % 192) * 32;
        for (int i = tid; i < 33 * 32; i += 512) OUT[i] = 0.f;
        __syncthreads();
        const int col = tid & 31, kc = tid >> 5;
        float acc[33];
#pragma unroll
        for (int m = 0; m < 33; ++m) acc[m] = 0.f;
        const float* W = wmod + (size_t)l * 1024 * MODW + col0 + col;
        for (int k4 = 0; k4 < 16; ++k4) {
            const int k = kc * 64 + k4 * 4;
            const float w0 = W[(size_t)(k + 0) * MODW], w1 = W[(size_t)(k + 1) * MODW], w2 = W[(size_t)(k + 2) * MODW], w3 = W[(size_t)(k + 3) * MODW];
#pragma unroll
            for (int m = 0; m < 33; ++m) { const f32x4 s = *(const LAS f32x4*)(S + m * 1024 + k); acc[m] += (s[0] * w0 + s[1] * w1) + (s[2] * w2 + s[3] * w3); }
        }
#pragma unroll
        for (int m = 0; m < 33; ++m) acc[m] += __shfl_xor(acc[m], 32);
        for (int w = 0; w < 8; ++w) {
            if ((tid >> 6) == w && (tid & 63) < 32) {
#pragma unroll
                for (int m = 0; m < 33; ++m) OUT[m * 32 + col] += acc[m];
            }
            __syncthreads();
        }
        for (int i = tid; i < 33 * 32; i += 512) { const int m = i >> 5, q = i & 31; MOD[(size_t)(l * 33 + m) * MODW + col0 + q] = OUT[i] + bmod[l * MODW + col0 + q]; }
        __syncthreads();
    }
}

__device__ __forceinline__ void norm_phase(const float* xin, const float* ctxin, const float* Xb, int from_inputs, const float* gvec, const float* mod, int sh_off, int sc_off,
                                           bf16* H, int skip_ctx, int gw, int NGW, int lane) {
    const int rpw = (MTOK + NGW - 1) / NGW; const int r0 = gw * rpw; int r1 = r0 + rpw; if (r1 > MTOK) r1 = MTOK;
    int cur = -1; f32x4 gs[4], shv[4];
#pragma unroll
    for (int j = 0; j < 4; ++j) { gs[j] = (f32x4){0.f, 0.f, 0.f, 0.f}; shv[j] = gs[j]; }
    for (int r = r0; r < r1; ++r) {
        const int b = r / TPB, t = r - b * TPB; const int midx = (t >= SEQ) ? 32 : b;
        if (skip_ctx && t >= SEQ) continue;
        if (midx != cur) { cur = midx;
#pragma unroll
            for (int j = 0; j < 4; ++j) { const int cidx = 4 * lane + 256 * j; const f32x4 g = *(const f32x4*)(gvec + cidx), sc = *(const f32x4*)(mod + (size_t)midx * MODW + sc_off + cidx);
                gs[j] = g * (sc + 1.0f); shv[j] = *(const f32x4*)(mod + (size_t)midx * MODW + sh_off + cidx); } }
        const float* xr = from_inputs ? (t < SEQ ? xin + ((size_t)b * SEQ + t) * DM : ctxin + ((size_t)b * CTXL + (t - SEQ)) * DM) : Xb + (size_t)r * DM;
        f32x4 v[4]; float ss = 0.f;
#pragma unroll
        for (int j = 0; j < 4; ++j) { v[j] = *(const f32x4*)(xr + 4 * lane + 256 * j); ss += (v[j][0] * v[j][0] + v[j][1] * v[j][1]) + (v[j][2] * v[j][2] + v[j][3] * v[j][3]); }
        const float rstd = 1.0f / sqrtf(wave_sum(ss) * (1.0f / DM) + EPS);
        bf16* hr = H + (size_t)r * DM;
#pragma unroll
        for (int j = 0; j < 4; ++j) { const f32x4 o = v[j] * rstd * gs[j] + shv[j]; v2u w; w.x = pk2(o[0], o[1]); w.y = pk2(o[2], o[3]); *(v2u*)(hr + 4 * lane + 256 * j) = w; }
    }
}
__device__ __forceinline__ void unpack8(v4u r, f32x4& a, f32x4& b) { a = (f32x4){bflo(r.x), bfhi(r.x), bflo(r.y), bfhi(r.y)}; b = (f32x4){bflo(r.z), bfhi(r.z), bflo(r.w), bfhi(r.w)}; }
__device__ __forceinline__ float sq8(const f32x4& a, const f32x4& b) { return ((a[0] * a[0] + a[1] * a[1]) + (a[2] * a[2] + a[3] * a[3])) + ((b[0] * b[0] + b[1] * b[1]) + (b[2] * b[2] + b[3] * b[3])); }
__device__ __forceinline__ void norm_phase_b(const bf16* Xb, const float* gvec, const float* mod, int sh_off, int sc_off, bf16* H, int skip_ctx, int gw, int NGW, int lane) {
    const int rpw = (((MTOK + NGW - 1) / NGW) + 1) & ~1; const int r0 = gw * rpw; int r1 = r0 + rpw; if (r1 > MTOK) r1 = MTOK;
    int cur = -1; f32x4 gs[2][2], shv[2][2];
#pragma unroll
    for (int j = 0; j < 2; ++j) { gs[j][0] = (f32x4){0.f, 0.f, 0.f, 0.f}; gs[j][1] = gs[j][0]; shv[j][0] = gs[j][0]; shv[j][1] = gs[j][0]; }
    for (int r = r0; r < r1; r += 2) {
        const int b = r / TPB, t = r - b * TPB; const int midx = (t >= SEQ) ? 32 : b;
        if (skip_ctx && t >= SEQ) continue;
        if (midx != cur) { cur = midx;
#pragma unroll
            for (int j = 0; j < 2; ++j)
#pragma unroll
                for (int q = 0; q < 2; ++q) { const int cidx = 8 * lane + 512 * j + 4 * q; const f32x4 g = *(const f32x4*)(gvec + cidx), sc = *(const f32x4*)(mod + (size_t)midx * MODW + sc_off + cidx);
                    gs[j][q] = g * (sc + 1.0f); shv[j][q] = *(const f32x4*)(mod + (size_t)midx * MODW + sh_off + cidx); } }
        const bf16* xr = Xb + (size_t)r * DM + 8 * lane;
        const v4u ra0 = *(const v4u*)(xr), ra1 = *(const v4u*)(xr + 512), rb0 = *(const v4u*)(xr + DM), rb1 = *(const v4u*)(xr + DM + 512);
        f32x4 a[2][2], c[2][2];
        unpack8(ra0, a[0][0], a[0][1]); unpack8(ra1, a[1][0], a[1][1]); unpack8(rb0, c[0][0], c[0][1]); unpack8(rb1, c[1][0], c[1][1]);
        float ss0 = sq8(a[0][0], a[0][1]) + sq8(a[1][0], a[1][1]), ss1 = sq8(c[0][0], c[0][1]) + sq8(c[1][0], c[1][1]);
#pragma unroll
        for (int o = 1; o < 64; o <<= 1) { ss0 += __shfl_xor(ss0, o); ss1 += __shfl_xor(ss1, o); }
        const float rstd0 = 1.0f / sqrtf(ss0 * (1.0f / DM) + EPS), rstd1 = 1.0f / sqrtf(ss1 * (1.0f / DM) + EPS);
        bf16* hr = H + (size_t)r * DM + 8 * lane;
#pragma unroll
        for (int j = 0; j < 2; ++j) {
            const f32x4 p0 = a[j][0] * rstd0 * gs[j][0] + shv[j][0], p1 = a[j][1] * rstd0 * gs[j][1] + shv[j][1];
            const f32x4 q0 = c[j][0] * rstd1 * gs[j][0] + shv[j][0], q1 = c[j][1] * rstd1 * gs[j][1] + shv[j][1];
            v4u w0; w0.x = pk2(p0[0], p0[1]); w0.y = pk2(p0[2], p0[3]); w0.z = pk2(p1[0], p1[1]); w0.w = pk2(p1[2], p1[3]); *(v4u*)(hr + 512 * j) = w0;
            v4u w1; w1.x = pk2(q0[0], q0[1]); w1.y = pk2(q0[2], q0[3]); w1.z = pk2(q1[0], q1[1]); w1.w = pk2(q1[2], q1[3]); *(v4u*)(hr + DM + 512 * j) = w1; }
    }
}
__device__ __forceinline__ void final_norm_phase(const bf16* Xb, const float* gvec, float* out, int gw, int NGW, int lane) {
    f32x4 g[2][2];
#pragma unroll
    for (int j = 0; j < 2; ++j)
#pragma unroll
        for (int q = 0; q < 2; ++q) g[j][q] = *(const f32x4*)(gvec + 8 * lane + 512 * j + 4 * q);
    for (int i = gw * 2; i < NB * SEQ; i += NGW * 2) {
        const int b = i / SEQ, t = i - b * SEQ; const bf16* xr = Xb + ((size_t)b * TPB + t) * DM + 8 * lane;
        const v4u ra0 = *(const v4u*)(xr), ra1 = *(const v4u*)(xr + 512), rb0 = *(const v4u*)(xr + DM), rb1 = *(const v4u*)(xr + DM + 512);
        f32x4 a[2][2], c[2][2];
        unpack8(ra0, a[0][0], a[0][1]); unpack8(ra1, a[1][0], a[1][1]); unpack8(rb0, c[0][0], c[0][1]); unpack8(rb1, c[1][0], c[1][1]);
        float ss0 = sq8(a[0][0], a[0][1]) + sq8(a[1][0], a[1][1]), ss1 = sq8(c[0][0], c[0][1]) + sq8(c[1][0], c[1][1]);
#pragma unroll
        for (int o = 1; o < 64; o <<= 1) { ss0 += __shfl_xor(ss0, o); ss1 += __shfl_xor(ss1, o); }
        const float rstd0 = 1.0f / sqrtf(ss0 * (1.0f / DM) + EPS), rstd1 = 1.0f / sqrtf(ss1 * (1.0f / DM) + EPS);
        float* orow = out + (size_t)i * DM + 8 * lane;
#pragma unroll
        for (int j = 0; j < 2; ++j)
#pragma unroll
            for (int q = 0; q < 2; ++q) { *(f32x4*)(orow + 512 * j + 4 * q) = a[j][q] * rstd0 * g[j][q]; *(f32x4*)(orow + DM + 512 * j + 4 * q) = c[j][q] * rstd1 * g[j][q]; }
    }
}

__device__ __forceinline__ v4u normrope8(v4u raw, const float* gain, int s, bool rope, float pos, const float (&invf)[8], float scale) {
    float v[8]; v[0] = bflo(raw.x); v[1] = bfhi(raw.x); v[2] = bflo(raw.y); v[3] = bfhi(raw.y); v[4] = bflo(raw.z); v[5] = bfhi(raw.z); v[6] = bflo(raw.w); v[7] = bfhi(raw.w);
    float ss = 0.f;
#pragma unroll
    for (int i = 0; i < 8; ++i) ss += v[i] * v[i];
    ss += __shfl_xor(ss, 1); ss += __shfl_xor(ss, 2); ss += __shfl_xor(ss, 4);
    const float rstd = 1.0f / sqrtf(ss * (1.0f / 64.0f) + EPS);
    const f32x4 g0 = *(const f32x4*)(gain + 8 * s), g1 = *(const f32x4*)(gain + 8 * s + 4);
    float y[8];
#pragma unroll
    for (int i = 0; i < 4; ++i) { y[i] = v[i] * rstd * g0[i]; y[4 + i] = v[4 + i] * rstd * g1[i]; }
    if (rope) {
#pragma unroll
        for (int i = 0; i < 8; ++i) { const float p = __shfl_xor(y[i], 2); const float ang = pos * invf[i]; const float cs = __cosf(ang), sn = __sinf(ang);
            y[i] = (s & 2) ? (y[i] * cs + p * sn) : (y[i] * cs - p * sn); }
    }
    v4u o; o.x = pk2(y[0] * scale, y[1] * scale); o.y = pk2(y[2] * scale, y[3] * scale); o.z = pk2(y[4] * scale, y[5] * scale); o.w = pk2(y[6] * scale, y[7] * scale);
    return o;
}
constexpr float QSCALE = 0.125f * 1.4426950408889634f;
__device__ __forceinline__ void normrope_phase(bf16* P, const float* kgain, int gw, int NGW, int lane) {
    const int s = lane & 7, q = lane >> 4, piece = lane & 15;
    float invf[8];
#pragma unroll
    for (int i = 0; i < 8; ++i) invf[i] = exp2f(-(float)(8 * (s & 1) + i) * (13.287712379549449f / 16.0f));
    const int rpw = (((MTOK + NGW - 1) / NGW) + 11) / 12 * 12; const int r0 = gw * rpw; int r1 = r0 + rpw; if (r1 > MTOK) r1 = MTOK;
    for (int r = r0; r < r1; r += 12) {
        v4u rk[3];
#pragma unroll
        for (int g = 0; g < 3; ++g) rk[g] = *(const v4u*)(P + (size_t)(r + 4 * g + q) * INW + 512 + 8 * piece);
#pragma unroll
        for (int g = 0; g < 3; ++g) {
            const int rr = r + 4 * g; const int b = rr / TPB, t = rr - b * TPB + q; const bool rope = t < SEQ;
            const float pos = (s < 4) ? (float)(t >> 6) : (float)(t & 63);
            *(v4u*)(P + (size_t)(rr + q) * INW + 512 + 8 * piece) = normrope8(rk[g], kgain, s, rope, pos, invf, 1.0f);
        }
    }
}

__device__ __forceinline__ void sgu_phase(const bf16* P, bf16* MIX, const bf16* Wsb  , const float* bs  , LAS unsigned char* lds, int wave, int gw, int NGW, int lane) {
    LAS unsigned short* vT = (LAS unsigned short*)(lds + wave * 17408);
    const int fr = lane & 15, fq = lane >> 4;
    for (int unit = gw; unit < (MTOK / 128) * 4; unit += NGW) {
        const int cidx = unit >> 2, g = unit & 3; const size_t row0 = (size_t)cidx * 128;
        v4u rawv[16];
#pragma unroll
        for (int it = 0; it < 16; ++it) { const int idx = it * 64 + lane, q = idx >> 3, pc = idx & 7; rawv[it] = *(const v4u*)(P + (row0 + q) * INW + 1024 + 64 * g + 8 * pc); }
#pragma unroll
        for (int it = 0; it < 16; ++it) { const int idx = it * 64 + lane, q = idx >> 3, pc = idx & 7;
            const v4u raw = rawv[it];
            LAS unsigned short* dst = vT + (8 * pc) * 136 + q;
            dst[0 * 136] = (unsigned short)(raw.x & 0xffffu); dst[1 * 136] = (unsigned short)(raw.x >> 16); dst[2 * 136] = (unsigned short)(raw.y & 0xffffu); dst[3 * 136] = (unsigned short)(raw.y >> 16);
            dst[4 * 136] = (unsigned short)(raw.z & 0xffffu); dst[5 * 136] = (unsigned short)(raw.z >> 16); dst[6 * 136] = (unsigned short)(raw.w & 0xffffu); dst[7 * 136] = (unsigned short)(raw.w >> 16); }
        LDS_WAIT(); asm volatile("" ::: "memory");
#pragma unroll 1
        for (int ph = 0; ph < 2; ++ph) {
            f32x4 acc[4][4];
#pragma unroll
            for (int pb = 0; pb < 4; ++pb)
#pragma unroll
                for (int db = 0; db < 4; ++db) acc[pb][db] = (f32x4){0.f, 0.f, 0.f, 0.f};
#pragma unroll
            for (int kq = 0; kq < 4; ++kq) {
                bf16x8 af[4], bfr[4];
#pragma unroll
                for (int db = 0; db < 4; ++db) af[db] = *(const LAS bf16x8*)(vT + (16 * db + fr) * 136 + 32 * kq + 8 * fq);
#pragma unroll
                for (int pb = 0; pb < 4; ++pb) bfr[pb] = *(const bf16x8*)(Wsb + (size_t)(g * 128 + 64 * ph + 16 * pb + fr) * 128 + 32 * kq + 8 * fq);
#pragma unroll
                for (int pb = 0; pb < 4; ++pb)
#pragma unroll
                    for (int db = 0; db < 4; ++db) acc[pb][db] = __builtin_amdgcn_mfma_f32_16x16x32_bf16(af[db], bfr[pb], acc[pb][db], 0, 0, 0);
            }
#pragma unroll
            for (int pb = 0; pb < 4; ++pb) { const int p = 64 * ph + 16 * pb + fr; const float bias = bs[g * 128 + p]; const size_t row = row0 + p;
#pragma unroll
                for (int db = 0; db < 4; ++db) { const int d = 16 * db + 4 * fq; const v2u uu = *(const v2u*)(P + row * INW + 768 + 64 * g + d);
                    v2u o; o.x = pk2(bflo(uu.x) * (acc[pb][db][0] + bias), bfhi(uu.x) * (acc[pb][db][1] + bias)); o.y = pk2(bflo(uu.y) * (acc[pb][db][2] + bias), bfhi(uu.y) * (acc[pb][db][3] + bias));
                    *(v2u*)(MIX + row * DM + 512 + 64 * g + d) = o; } }
        }
        LDS_WAIT(); asm volatile("" ::: "memory");
    }
}

__device__ __forceinline__ void pool_phase(const bf16* P, bf16* MIX, const bf16* WpT  , const float* pscale  , LAS unsigned char* lds, int wave, int gw, int NGW, int lane) {
    const int fr = lane & 15, fq = lane >> 4;
    LAS unsigned char* img = lds + wave * 16896;
    for (int tb = gw; tb < MTOK / 16; tb += NGW) {
        const int r0 = tb * 16; const int b = r0 / TPB, t0 = r0 - b * TPB; const int tt0 = (t0 < SEQ) ? t0 : t0 - SEQ, L = (t0 < SEQ) ? SEQ : CTXL;
        const bf16* seg = P + (size_t)(r0 - tt0) * INW + 1280;
#pragma unroll
        for (int it = 0; it < 16; ++it) { const int idx = it * 64 + lane, row = idx >> 5, pc = idx & 31;
            int tp = tt0 - 8 + row; tp = tp < 0 ? 0 : (tp > L - 1 ? L - 1 : tp);
            *(LAS v4u*)(img + row * 528 + pc * 16) = *(const v4u*)(seg + (size_t)tp * INW + 8 * pc); }
        LDS_WAIT(); asm volatile("" ::: "memory");
        const int tt = tt0 + fr; const int r = r0 + fr;
#pragma unroll 1
        for (int gi = 0; gi < 4; ++gi) {
            const int w = 2 << gi, left = w >> 1, right = w - 1 - left;
            int lo = tt - left; if (lo < 0) lo = 0; int hi = tt + right; if (hi > L - 1) hi = L - 1;
            const float rc = 1.0f / (float)(hi - lo + 1);
            bf16x8 yf[2];
#pragma unroll
            for (int ks = 0; ks < 2; ++ks) {
                const LAS unsigned char* src = img + (64 * gi + 32 * ks + 8 * fq) * 2;
                float sum[8];
#pragma unroll
                for (int i = 0; i < 8; ++i) sum[i] = 0.f;
                for (int tp = lo; tp <= hi; ++tp) { const v4u raw = *(const LAS v4u*)(src + (tp - tt0 + 8) * 528);
                    sum[0] += bflo(raw.x); sum[1] += bfhi(raw.x); sum[2] += bflo(raw.y); sum[3] += bfhi(raw.y); sum[4] += bflo(raw.z); sum[5] += bfhi(raw.z); sum[6] += bflo(raw.w); sum[7] += bfhi(raw.w); }
                const v4u own = *(const LAS v4u*)(src + (fr + 8) * 528);
                v4u pkd; pkd.x = pk2(sum[0] * rc - bflo(own.x), sum[1] * rc - bfhi(own.x)); pkd.y = pk2(sum[2] * rc - bflo(own.y), sum[3] * rc - bfhi(own.y));
                pkd.z = pk2(sum[4] * rc - bflo(own.z), sum[5] * rc - bfhi(own.z)); pkd.w = pk2(sum[6] * rc - bflo(own.w), sum[7] * rc - bfhi(own.w));
                yf[ks] = __builtin_bit_cast(bf16x8, pkd);
            }
#pragma unroll
            for (int eb = 0; eb < 4; ++eb) {
                f32x4 acc = (f32x4){0.f, 0.f, 0.f, 0.f};
#pragma unroll
                for (int ks = 0; ks < 2; ++ks) { const bf16x8 af = *(const bf16x8*)(WpT + (size_t)(gi * 64 + 16 * eb + fr) * 64 + 32 * ks + 8 * fq); acc = __builtin_amdgcn_mfma_f32_16x16x32_bf16(af, yf[ks], acc, 0, 0, 0); }
                const int e = 16 * eb + 4 * fq; const f32x4 psc = *(const f32x4*)(pscale + 64 * gi + e);
                v2u o; o.x = pk2(acc[0] * psc[0], acc[1] * psc[1]); o.y = pk2(acc[2] * psc[2], acc[3] * psc[3]);
                *(v2u*)(MIX + (size_t)r * DM + 768 + 64 * gi + e) = o;
            }
        }
        LDS_WAIT(); asm volatile("" ::: "memory");
    }
}

__device__ __forceinline__ void fixup_phase(bf16* A, const float* SB, const float* cw, int skip_ctx, int gw, int NGW, int lane) {
    for (int item = gw; item < NTILE * 8; item += NGW) {
        const int pm = item >> 3, e = item & 7; const int b = pm / 9, j = pm - 9 * b;
        if (skip_ctx && j == 8) continue;
        int npm = -1, ne = 0;
        if ((e & 1) == 0) { if (e > 0) { npm = pm; ne = e - 1; } else if (j >= 1 && j <= 7) { npm = pm - 1; ne = 7; } }
        else { if (e < 7) { npm = pm; ne = e + 1; } else if (j <= 6) { npm = pm + 1; ne = 0; } }
        if (npm < 0) continue;
        const float* own = SB + (size_t)(pm * 8 + e) * 4 * 2816; const float* nbr = SB + (size_t)(npm * 8 + ne) * 4 * 2816;
        const float* wt = cw + ((e & 1) ? 2 * FF2 : 0);
        bf16* arow = A + (size_t)(pm * 256 + 64 * (e >> 1) + ((e & 1) ? 63 : 0)) * FF;
#pragma unroll 4
        for (int i = lane; i < FF / 4; i += 64) { const int jj = 4 * i;
            const f32x4 zg = *(const f32x4*)(own + 2 * 2816 + jj) + *(const f32x4*)(wt + jj) * *(const f32x4*)(nbr + jj);
            const f32x4 zv = *(const f32x4*)(own + 3 * 2816 + jj) + *(const f32x4*)(wt + FF + jj) * *(const f32x4*)(nbr + 2816 + jj);
            v2u o; o.x = pk2(pg8::silu_f(zg[0]) * zv[0], pg8::silu_f(zg[1]) * zv[1]); o.y = pk2(pg8::silu_f(zg[2]) * zv[2], pg8::silu_f(zg[3]) * zv[3]);
            *(v2u*)(arow + jj) = o; }
    }
}
#ifndef REP_LIGHT
#define REP_LIGHT 1
#endif
#ifndef REP_ATTN
#define REP_ATTN 1
#endif
#ifndef REP_SYNC
#define REP_SYNC 1
#endif
__global__ void __launch_bounds__(512, 2) mk_fwd(Args args) {
    extern __shared__ __attribute__((aligned(16))) unsigned char lds[];
    cg::grid_group grid = cg::this_grid();
    LAS unsigned char* l3 = (LAS unsigned char*)lds;
    int tid = pg8::opaque_tid(), lane = tid & 63, wave = __builtin_amdgcn_readfirstlane(tid >> 6);
    const int G = gridDim.x, bx = blockIdx.x;
    const int vcu = (G % 8 == 0) ? (bx % 8) * (G / 8) + bx / 8 : bx;
    int gw = vcu * 8 + wave; const int NGW = G * 8;
    unsigned char* ws = args.ws;
#define RELAUNDER() do { ws = args.ws; asm volatile("" : "+s"(ws)); tid = pg8::opaque_tid(); lane = tid & 63; wave = __builtin_amdgcn_readfirstlane(tid >> 6); gw = vcu * 8 + wave; } while (0)
    float* PRM = (float*)(ws + WS_PRM);
#define GSYNC() do { for (int rs_ = 0; rs_ < REP_SYNC; ++rs_) xcd_barrier(xbar); RELAUNDER(); } while (0)
#define MOD ((float*)(ws + WS_MOD))
#define WSB ((bf16*)(ws + WS_WSB))
#define WPT ((bf16*)(ws + WS_WPT))
#define SB ((float*)(ws + WS_SB))
#define X ((bf16*)(ws + WS_X))
#define H ((bf16*)(ws + WS_H))
#define P ((bf16*)(ws + WS_P))
#define MIX ((bf16*)(ws + WS_MIX))
#define A ((bf16*)(ws + WS_A))
#define x_in (args.in[0])
#define ctx_in (args.in[2])
#define PRML ((const float*)(ws + WS_PRM) + (size_t)l * PRM_L)

    if (bx == 0) for (int i = tid; i < XCD_BAR_WORDS; i += 512) ((unsigned*)(ws + WS_BAR))[i] = 0u;
    if (tid < 2) ((volatile LAS unsigned*)(l3 + LDS_BYTES - 64))[tid] = 0u;
    __syncthreads();
#if !defined(ONLY) || ONLY==1
    mod_phase(args, l3, tid);
#endif

    {
        LAS float* scr = (LAS float*)(l3 + wave * 16384);
        constexpr int I_IN = 16 * 48, I_OUT = 16 * 32, I_UP = 16 * 176, I_DN = 44 * 32, I_L = I_IN + I_OUT + I_UP + I_DN;
        for (int it = gw; it < NLAYER * I_L; it += NGW) {
            const int l = it / I_L; int r = it - l * I_L;
            if (r < I_IN) { p0_transpose_item(args.in[7] + (size_t)l * DM * INW, DM, INW, (bf16*)(ws + WS_WIN) + (size_t)l * INW * DM, false, scr, r, lane); continue; } r -= I_IN;
            if (r < I_OUT) { p0_transpose_item(args.in[14] + (size_t)l * DM * DM, DM, DM, (bf16*)(ws + WS_WOUT) + (size_t)l * DM * DM, false, scr, r, lane); continue; } r -= I_OUT;
            if (r < I_UP) { p0_transpose_item(args.in[16] + (size_t)l * DM * FF2, DM, FF2, (bf16*)(ws + WS_WUP) + (size_t)l * FF2 * DM, true, scr, r, lane); continue; } r -= I_UP;
            p0_transpose_item(args.in[19] + (size_t)l * FF * DM, FF, DM, (bf16*)(ws + WS_WDN) + (size_t)l * DM * FF, false, scr, r, lane);
        }
        const int gt = gw * 64 + lane, NGT = NGW * 64;
        for (int l = 0; l < NLAYER; ++l) { float* pl = PRM + (size_t)l * PRM_L;
            for (int i = gt; i < 1024; i += NGT) { pl[PRM_N1G + i] = args.in[6][l * 1024 + i]; pl[PRM_N2G + i] = args.in[15][l * 1024 + i]; }
            for (int i = gt; i < 64; i += NGT) { pl[PRM_QG + i] = args.in[8][l * 64 + i]; pl[PRM_KG + i] = args.in[9][l * 64 + i]; }
            for (int i = gt; i < 512; i += NGT) pl[PRM_BS + i] = args.in[11][l * 512 + i];
            for (int i = gt; i < 256; i += NGT) pl[PRM_PSC + i] = args.in[13][l * 256 + i];
            for (int i = gt; i < 3 * FF2; i += NGT) pl[PRM_CW + i] = args.in[17][(size_t)l * 3 * FF2 + i];
            for (int i = gt; i < FF2; i += NGT) pl[PRM_CB + i] = args.in[18][(size_t)l * FF2 + i]; }
        for (int i = gt; i < 1024; i += NGT) PRM[NLAYER * PRM_L + i] = args.in[20][i];
        for (int i = gt; i < NLAYER * 4 * 128 * 128; i += NGT) WSB[i] = (bf16)(pk2(args.in[10][i], 0.f) & 0xffffu);
        for (int i = gt; i < NLAYER * 4 * 64 * 64; i += NGT) { const int d = i & 63, e = (i >> 6) & 63, lg = i >> 12; WPT[i] = (bf16)(pk2(args.in[12][(size_t)lg * 4096 + d * 64 + e], 0.f) & 0xffffu); }
    }
    grid.sync(); RELAUNDER();
    XcdBarrier xbar = xcd_barrier_post((unsigned*)(ws + WS_BAR), (volatile LAS unsigned*)(l3 + LDS_BYTES - 64));

    for (int l = 0; l < NLAYER; ++l) {
        const int last = (l == NLAYER - 1);
#define mod (MOD + (size_t)l * 33 * MODW)
#define Win_t ((const bf16*)(ws + WS_WIN) + (size_t)l * INW * DM)
#define Wout_t ((const bf16*)(ws + WS_WOUT) + (size_t)l * DM * DM)
#define Wup_t ((const bf16*)(ws + WS_WUP) + (size_t)l * FF2 * DM)
#define Wdn_t ((const bf16*)(ws + WS_WDN) + (size_t)l * DM * FF)
#if !defined(ONLY) || ONLY==2
        for (int rep_ = 0; rep_ < REP_LIGHT; ++rep_)
        if (l == 0) norm_phase(x_in, ctx_in, nullptr, 1, PRML + PRM_N1G, mod, 0, 1024, H, 0, gw, NGW, lane);
        else norm_phase_b(X, PRML + PRM_N1G, mod, 0, 1024, H, 0, gw, NGW, lane);
#endif

        GSYNC();
#if !defined(ONLY) || ONLY==3
        { pg8::Gemm g{H, Win_t, MTOK, INW, DM}; pg8::TileOrder S; S.init(NTILE, INW, G, bx, 0);
          pg8::EpiBf16<0> E{P, INW, nullptr, 0, 0, 1.f};
          pg8::gemm_phase<pg8::EpiBf16<0>, pg8::TileOrder, true, true>(l3, g, S, E); }
#endif

        GSYNC();
#if !defined(ONLY) || ONLY==4
        normrope_phase(P, PRML + PRM_KG, gw, NGW, lane);
#endif

#if !defined(ONLY) || ONLY==5
        for (int rep_ = 0; rep_ < REP_LIGHT; ++rep_) {
        sgu_phase(P, MIX, WSB + (size_t)l * 4 * 128 * 128, PRML + PRM_BS, l3, wave, gw, NGW, lane);
#endif

#if !defined(ONLY) || ONLY==6
        pool_phase(P, MIX, WPT + (size_t)l * 4 * 64 * 64, PRML + PRM_PSC, l3, wave, gw, NGW, lane); }
#endif

        GSYNC();
        {
#if !defined(ONLY) || ONLY==7
            for (int rep_ = 0; rep_ < REP_ATTN; ++rep_)
            for (int bh = vcu; bh < NB * 8; bh += G) {
                const int b = bh >> 3, h = bh & 7;
                const attn_body::bf16* Pb = (const attn_body::bf16*)P + (size_t)b * TPB * INW;
                attn_body::bf16* Ob = (attn_body::bf16*)MIX + (size_t)b * TPB * DM + h * 64;
                const attn_body::bf16* Kb = Pb + 512 + (h >> 2) * 64; const attn_body::bf16* Vb = Pb + 640 + (h >> 2) * 64;
                const int nu = last ? 8 : 9;
                for (int qb = 0; qb < nu; ++qb) {
                    const attn_body::bf16* Qu = Pb + (size_t)(qb * 256) * INW + h * 64;
                    if (qb < 8) attn_body::attn_unit<8>(Qu, Kb, Vb, Ob + (size_t)(qb * 256) * DM, (SEQ + CTXL) / 64, (char*)lds, PRML + PRM_QG, qb * 256);
                    else attn_body::attn_unit<8>(Qu, Kb + (size_t)SEQ * INW, Vb + (size_t)SEQ * INW, Ob + (size_t)(qb * 256) * DM, CTXL / 64, (char*)lds, PRML + PRM_QG, -1);
                }
            }
#endif

        }
        GSYNC();
#if !defined(ONLY) || ONLY==8
        { pg8::Gemm g{MIX, Wout_t, MTOK, DM, DM}; pg8::TileOrder S; S.init(last ? NB * 8 : NTILE, DM, G, bx, last);
          pg8::EpiRes E{x_in, ctx_in, X, mod + 2048, l == 0};
          pg8::gemm_phase<pg8::EpiRes, pg8::TileOrder, true, true>(l3, g, S, E); }
#endif

        GSYNC();
        for (int rep_ = 0; rep_ < REP_LIGHT; ++rep_)
        norm_phase_b(X, PRML + PRM_N2G, mod, 3072, 4096, H, last, gw, NGW, lane);
        GSYNC();
#if !defined(ONLY) || ONLY==9
        { pg8::Gemm g{H, Wup_t, MTOK, FF2, DM}; pg8::TileOrder S; S.init(last ? NB * 8 : NTILE, FF2, G, bx, last);
          pg8::EpiUpGate E{A, SB, PRML + PRM_CW, PRML + PRM_CB, (LAS float*)(l3 + 131072 + 4096)};
          pg8::gemm_phase<pg8::EpiUpGate, pg8::TileOrder, true, true>(l3, g, S, E); }
#endif

        GSYNC();
#if !defined(ONLY) || ONLY==10
        for (int rep_ = 0; rep_ < REP_LIGHT; ++rep_)
        fixup_phase(A, SB, PRML + PRM_CW, last, gw, NGW, lane);
#endif

        GSYNC();
#if !defined(ONLY) || ONLY==11
        { pg8::Gemm g{A, Wdn_t, MTOK, DM, FF}; pg8::TileOrder S; S.init(last ? NB * 8 : NTILE, DM, G, bx, last);
          pg8::EpiRes E{x_in, ctx_in, X, mod + 5120, 0};
          pg8::gemm_phase<pg8::EpiRes, pg8::TileOrder, true, true>(l3, g, S, E); }
#endif

        GSYNC();
    }
    for (int rep_ = 0; rep_ < REP_LIGHT; ++rep_)
    final_norm_phase(X, (const float*)(ws + WS_PRM) + NLAYER * PRM_L, args.out, gw, NGW, lane);
}

extern "C" void kernel_launch(void* const* d_in, const int* in_sizes, int n_in, void* d_out, int out_size, void* d_ws, size_t ws_size, hipStream_t stream) {
    static int grid = 0;
    if (grid == 0) {
        if (n_in != 21 || in_sizes[0] != NB * SEQ * DM || out_size != NB * SEQ * DM || ws_size < WS_END) { fprintf(stderr, "kernel_launch: unexpected shapes (n_in %d, in0 %d, out %d, ws %zu); nothing launched\n", n_in, n_in > 0 ? in_sizes[0] : -1, out_size, ws_size); grid = -1; return; }
        int dev = 0, cus = 0, per_cu = 0;
        if (hipGetDevice(&dev) != hipSuccess || hipDeviceGetAttribute(&cus, hipDeviceAttributeMultiprocessorCount, dev) != hipSuccess) { grid = -1; return; }
        if (hipFuncSetAttribute((const void*)mk_fwd, hipFuncAttributeMaxDynamicSharedMemorySize, LDS_BYTES) != hipSuccess) { fprintf(stderr, "kernel_launch: hipFuncSetAttribute failed\n"); grid = -1; return; }
        if (hipOccupancyMaxActiveBlocksPerMultiprocessor(&per_cu, (const void*)mk_fwd, 512, LDS_BYTES) != hipSuccess || per_cu < 1) { fprintf(stderr, "kernel_launch: occupancy query says %d\n", per_cu); per_cu = 1; }
        (void)hipGetLastError();
        grid = cus * 1;
    }
    if (grid < 0) return;
    Args a{};
    for (int i = 0; i < 21; ++i) a.in[i] = (const float*)d_in[i];
    a.out = (float*)d_out; a.ws = (unsigned char*)d_ws;
    void* kargs[] = {&a};
    hipError_t e = hipLaunchCooperativeKernel((const void*)mk_fwd, dim3(grid), dim3(512), kargs, LDS_BYTES, stream);
    if (e != hipSuccess) fprintf(stderr, "cooperative launch failed: %s (grid %d)\n", hipGetErrorString(e), grid);
}
```

```cpp
#include <hip/hip_runtime.h>
#include <hip/hip_cooperative_groups.h>
#include <hip/hip_bf16.h>
#include <cstdio>
#include <cstdint>
#include <cmath>
namespace cg = cooperative_groups;
namespace pg8 { __device__ __forceinline__ int opaque_tid() { int t = threadIdx.x; asm volatile("" : "+v"(t)); return t; } }
namespace pg8 {
#define PG8_LAS __attribute__((address_space(3)))
typedef unsigned short bf16_t;
typedef short bf16x8 __attribute__((ext_vector_type(8)));
typedef float f32x4 __attribute__((ext_vector_type(4)));
typedef unsigned u32x4 __attribute__((ext_vector_type(4)));
constexpr int BM = 256, BK = 64, HALF = 128, HTB = HALF * BK * 2  , STAGE_BYTES = 8 * HTB, NXCD = 8, WGM = 4;

__host__ __device__ __forceinline__ int lds_byte(int r, int c) { const int st = (r >> 4) * 2 + (c >> 5), rr = r & 15, cc = c & 31, ob = rr * 64 + cc * 2; return st * 1024 + (ob ^ (((ob >> 9) & 1) << 5)); }
__host__ __device__ __forceinline__ void stage_rc(int b, int& R, int& C) { const int st = b / 1024, sb = b % 1024, swz = sb ^ (((sb >> 9) & 1) << 5); R = (st >> 1) * 16 + swz / 64; C = (st & 1) * 32 + (swz % 64) / 2; }
__host__ __device__ __forceinline__ int perm32(int rho) { const int n = rho >> 4, i = rho & 15; return 8 * (i >> 2) + 4 * n + (i & 3); }

struct Unit { int pm, pn; };
struct Gemm { const bf16_t* A; const bf16_t* Bt; int M, N, K; };

struct StaticOrder {
    int nM, nN, nwg, G, c;
    __host__ __device__ void init(int M, int N, int G_, int c_) { nM = M / BM; nN = N / BM; nwg = nM * nN; G = G_; c = c_; }
    __host__ __device__ bool next(int i, Unit& u) const {
        const long L = (long)i * G + c; if (L >= nwg) return false;
        int wgid = (int)L; { const int q = nwg / NXCD, r = nwg % NXCD, xcd = wgid % NXCD, off = wgid / NXCD; wgid = (xcd < r ? xcd * (q + 1) : r * (q + 1) + (xcd - r) * q) + off; }
        const int nig = WGM * nN, gid = wgid / nig, fm = gid * WGM, gsz = (nM - fm) < WGM ? (nM - fm) : WGM;
        u.pm = fm + ((wgid % nig) % gsz); u.pn = (wgid % nig) / gsz; return true;
    }
    __device__ __forceinline__ void a_ready(const Unit&) const {}
    __device__ __forceinline__ void done(const Unit&) const {}
};

__device__ __forceinline__ unsigned cvt_pk_bf16(float lo, float hi) { unsigned r; asm volatile("v_cvt_pk_bf16_f32 %0, %1, %2" : "=v"(r) : "v"(lo), "v"(hi)); return r; }
typedef float f32x2 __attribute__((ext_vector_type(2)));
__device__ __forceinline__ f32x2 gelu_pk(f32x2 v) {
    const f32x2 av = __builtin_elementwise_abs(v), d = av * 0.2316418882f + 1.0f;
    f32x2 t; t.x = __builtin_amdgcn_rcpf(d.x); t.y = __builtin_amdgcn_rcpf(d.y);
    f32x2 q = t * 0.5307027145f + (-0.7265760135f); q = q * t + 0.7107068705f; q = q * t + (-0.142248368f); q = q * t + 0.127414796f; q = q * t;
    const f32x2 s = (v * v) * (-0.72134752044f);
    f32x2 e; e.x = __builtin_amdgcn_exp2f(s.x); e.y = __builtin_amdgcn_exp2f(s.y);
    const f32x2 m = v * (q * e), r = v - m;
    f32x2 o; o.x = v.x < 0.f ? m.x : r.x; o.y = v.y < 0.f ? m.y : r.y; return o;
}

template <int ACT  > struct EpiBf16 {
    static constexpr bool PERM = true, AFTER_DRAIN = false, WANT_NEXT = false; static_assert(ACT == 0 || ACT == 1, "EpiBf16: ACT is 0 (none) or 1 (gelu_pk)");
    bf16_t* O; int ldc; const float* bias; int split_cols; size_t split_stride; float scale0;
    __device__ __forceinline__ void operator()(const f32x4 (&acc)[2][2][4][2], const Unit& u, int wr, int wc, int fr, int fq) const {
        const int row0 = u.pm * BM + wr * 64 + fr; int colt = u.pn * BM; bf16_t* base = O;
        float sc = 1.f; if (split_cols) { const int t = colt / split_cols; base += (size_t)t * split_stride; colt -= t * split_cols; if (t == 0) sc = scale0; }
        const int col0 = colt + wc * 32 + 8 * fq, bcol0 = u.pn * BM + wc * 32 + 8 * fq;
        f32x4 bv[2][2];
#pragma unroll
        for (int bj = 0; bj < 2; ++bj)
#pragma unroll
            for (int n = 0; n < 2; ++n) bv[bj][n] = bias ? *(const f32x4*)(bias + bcol0 + bj * HALF + 4 * n) : (f32x4){0.f, 0.f, 0.f, 0.f};
#pragma unroll
        for (int ai = 0; ai < 2; ++ai)
#pragma unroll
            for (int m = 0; m < 4; ++m) { bf16_t* rowp = base + (size_t)(row0 + ai * HALF + m * 16) * ldc + col0;
#pragma unroll
                for (int bj = 0; bj < 2; ++bj) { f32x4 v0 = acc[ai][bj][m][0] + bv[bj][0], v1 = acc[ai][bj][m][1] + bv[bj][1];
                    if (ACT == 1) { f32x2 a = gelu_pk((f32x2){v0[0], v0[1]}), b = gelu_pk((f32x2){v0[2], v0[3]}), c = gelu_pk((f32x2){v1[0], v1[1]}), d = gelu_pk((f32x2){v1[2], v1[3]});
                        v0 = (f32x4){a.x, a.y, b.x, b.y}; v1 = (f32x4){c.x, c.y, d.x, d.y}; }
                    v0 = v0 * sc; v1 = v1 * sc; u32x4 w; w.x = cvt_pk_bf16(v0[0], v0[1]); w.y = cvt_pk_bf16(v0[2], v0[3]); w.z = cvt_pk_bf16(v1[0], v1[1]); w.w = cvt_pk_bf16(v1[2], v1[3]);
                    *(u32x4*)(rowp + bj * HALF) = w; } }
    }
};
__device__ __forceinline__ unsigned cvtpk2(float lo, float hi) { typedef float f2 __attribute__((ext_vector_type(2))); typedef __bf16 b2 __attribute__((ext_vector_type(2))); f2 v = {lo, hi}; b2 b = __builtin_convertvector(v, b2); return __builtin_bit_cast(unsigned, b); }
template <int CTRL> __device__ __forceinline__ float dppz(float v) { return __builtin_bit_cast(float, __builtin_amdgcn_update_dpp(0, __builtin_bit_cast(int, v), CTRL, 0xf, 0xf, true)); }
template <int CTRL> __device__ __forceinline__ f32x4 dppz4(f32x4 v) { f32x4 r; r[0] = dppz<CTRL>(v[0]); r[1] = dppz<CTRL>(v[1]); r[2] = dppz<CTRL>(v[2]); r[3] = dppz<CTRL>(v[3]); return r; }
#ifdef V_NOSILU
__device__ __forceinline__ float silu_f(float x) { return x; }
#else
__device__ __forceinline__ float silu_f(float x) { return x * __builtin_amdgcn_rcpf(1.0f + __builtin_amdgcn_exp2f(-1.4426950408889634f * x)); }
#endif

struct EpiRes {
    static constexpr bool PERM = true, AFTER_DRAIN = false, WANT_NEXT = false;
    const float* xin; const float* ctxin; bf16_t* X; const float* gate; int from_inputs;
    __device__ __forceinline__ void operator()(const f32x4 (&acc)[2][2][4][2], const Unit& u, int wr, int wc, int fr, int fq) const {
        const int b = u.pm / 9, j = u.pm - 9 * b, midx = (j == 8) ? 32 : b;
        bf16_t* xt = X + (size_t)u.pm * 256 * 1024;
        const int col0 = u.pn * BM + wc * 32 + 8 * fq;
        f32x4 gv[2][2];
#pragma unroll
        for (int bj = 0; bj < 2; ++bj)
#pragma unroll
            for (int n = 0; n < 2; ++n) gv[bj][n] = *(const f32x4*)(gate + (size_t)midx * 6144 + col0 + bj * HALF + n * 4);
        if (from_inputs) {
            const float* basef = (j < 8 ? xin + (size_t)(b * 2048 + 256 * j) * 1024 : ctxin + (size_t)b * 256 * 1024);
#pragma unroll
            for (int ai = 0; ai < 2; ++ai) {
                f32x4 fb[4][2][2];
#pragma unroll
                for (int m = 0; m < 4; ++m)
#pragma unroll
                    for (int bj = 0; bj < 2; ++bj) { const float* p = basef + (unsigned)((ai * HALF + wr * 64 + m * 16 + fr) * 1024 + col0) + bj * HALF; fb[m][bj][0] = *(const f32x4*)p; fb[m][bj][1] = *(const f32x4*)(p + 4); }
                asm volatile("" ::: "memory");
#pragma unroll
                for (int m = 0; m < 4; ++m) { const unsigned off = (unsigned)((ai * HALF + wr * 64 + m * 16 + fr) * 1024 + col0);
#pragma unroll
                    for (int bj = 0; bj < 2; ++bj) {
                        const f32x4 o0 = fb[m][bj][0] + gv[bj][0] * acc[ai][bj][m][0], o1 = fb[m][bj][1] + gv[bj][1] * acc[ai][bj][m][1];
                        u32x4 w; w.x = cvtpk2(o0[0], o0[1]); w.y = cvtpk2(o0[2], o0[3]); w.z = cvtpk2(o1[0], o1[1]); w.w = cvtpk2(o1[2], o1[3]);
                        *(u32x4*)(xt + off + bj * HALF) = w; } }
                asm volatile("" ::: "memory");
            }
        } else {
            u32x4 rb[2][4][2];
#pragma unroll
            for (int ai = 0; ai < 2; ++ai)
#pragma unroll
                for (int m = 0; m < 4; ++m)
#pragma unroll
                    for (int bj = 0; bj < 2; ++bj) rb[ai][m][bj] = *(const u32x4*)(xt + (unsigned)((ai * HALF + wr * 64 + m * 16 + fr) * 1024 + col0) + bj * HALF);
            asm volatile("" ::: "memory");
#pragma unroll
            for (int ai = 0; ai < 2; ++ai)
#pragma unroll
                for (int m = 0; m < 4; ++m) { const unsigned off = (unsigned)((ai * HALF + wr * 64 + m * 16 + fr) * 1024 + col0);
#pragma unroll
                    for (int bj = 0; bj < 2; ++bj) { const u32x4 r = rb[ai][m][bj];
                        const f32x4 b0 = (f32x4){__uint_as_float(r.x << 16), __uint_as_float(r.x & 0xffff0000u), __uint_as_float(r.y << 16), __uint_as_float(r.y & 0xffff0000u)};
                        const f32x4 b1 = (f32x4){__uint_as_float(r.z << 16), __uint_as_float(r.z & 0xffff0000u), __uint_as_float(r.w << 16), __uint_as_float(r.w & 0xffff0000u)};
                        const f32x4 o0 = b0 + gv[bj][0] * acc[ai][bj][m][0], o1 = b1 + gv[bj][1] * acc[ai][bj][m][1];
                        u32x4 w; w.x = cvtpk2(o0[0], o0[1]); w.y = cvtpk2(o0[2], o0[3]); w.z = cvtpk2(o1[0], o1[1]); w.w = cvtpk2(o1[2], o1[3]);
                        *(u32x4*)(xt + off + bj * HALF) = w; } }
        }
    }
};

struct EpiUpGate {
    static constexpr bool PERM = true, AFTER_DRAIN = false, WANT_NEXT = true;
    bf16_t* A; float* SB; const float* cw; const float* cb; PG8_LAS float* cl  ;
    __device__ __forceinline__ void operator()(const f32x4 (&acc)[2][2][4][2], const Unit& u, const Unit& nxt, bool has_next, int ui, int wr, int wc, int fr, int fq) const {
        const int jc = u.pn * 128 + wc * 32 + 8 * fq;
        PG8_LAS float* cwv = cl + ((wr * 4 + wc) * 2 + (ui & 1)) * 256;
        PG8_LAS float* cwn = cl + ((wr * 4 + wc) * 2 + ((ui + 1) & 1)) * 256;
        const int v_ = fr + 16 * fq, hv_s = v_ >> 5, k_s = (v_ >> 3) & 3, c4_s = v_ & 7;
        const float* srcb = (k_s < 3 ? cw + k_s * 5632 : cb) + hv_s * 2816 + wc * 32 + 4 * c4_s;
        if (ui == 0) { *(PG8_LAS f32x4*)(cwv + v_ * 4) = *(const f32x4*)(srcb + u.pn * 128); asm volatile("s_waitcnt lgkmcnt(0)" ::: "memory"); }
        f32x4 nextc = (f32x4){0.f, 0.f, 0.f, 0.f};
        if (has_next) nextc = *(const f32x4*)(srcb + nxt.pn * 128);
#define CWL(hv_, k_, n_) (*(const PG8_LAS f32x4*)(cwv + ((hv_) * 4 + (k_)) * 32 + 8 * fq + 4 * (n_)))
#if 1
#pragma unroll
        for (int n = 0; n < 2; ++n) {
            const int j0 = jc + 4 * n;
            const f32x4 w0g = CWL(0, 0, n), w1g = CWL(0, 1, n), w2g = CWL(0, 2, n), bg = CWL(0, 3, n);
            const f32x4 w0v = CWL(1, 0, n), w1v = CWL(1, 1, n), w2v = CWL(1, 2, n), bv = CWL(1, 3, n);
#pragma unroll
            for (int ai = 0; ai < 2; ++ai) {
                float* sb = SB + ((size_t)(u.pm * 8 + 2 * (2 * ai + wr)) * 4) * 2816 + j0;
                { const f32x4 zg = acc[ai][0][0][n], zv = acc[ai][1][0][n];
                  const f32x4 cgv = w1g * zg + w2g * dppz4<0x101>(zg) + bg, cvv = w1v * zv + w2v * dppz4<0x101>(zv) + bv;
                  if (fr == 0) { *(f32x4*)(sb) = zg; *(f32x4*)(sb + 2816) = zv; *(f32x4*)(sb + 2 * 2816) = cgv; *(f32x4*)(sb + 3 * 2816) = cvv; } }
                { const f32x4 zg = acc[ai][0][3][n], zv = acc[ai][1][3][n];
                  const f32x4 cgv = w1g * zg + w0g * dppz4<0x111>(zg) + bg, cvv = w1v * zv + w0v * dppz4<0x111>(zv) + bv;
                  if (fr == 15) { float* sb1 = sb + 4 * 2816; *(f32x4*)(sb1) = zg; *(f32x4*)(sb1 + 2816) = zv; *(f32x4*)(sb1 + 2 * 2816) = cgv; *(f32x4*)(sb1 + 3 * 2816) = cvv; } }
                asm volatile("" ::: "memory"); __builtin_amdgcn_sched_barrier(0);
            }
        }
#endif
        unsigned pk[2][4][2];
#pragma unroll
        for (int n = 0; n < 2; ++n) {
            const int j0 = jc + 4 * n;
            const f32x4 w0g = CWL(0, 0, n), w1g = CWL(0, 1, n), w2g = CWL(0, 2, n), bg = CWL(0, 3, n);
            const f32x4 w0v = CWL(1, 0, n), w1v = CWL(1, 1, n), w2v = CWL(1, 2, n), bv = CWL(1, 3, n);
#pragma unroll
            for (int ai = 0; ai < 2; ++ai) {
#pragma unroll
                for (int m = 0; m < 4; ++m) {
                    const f32x4 zg = acc[ai][0][m][n], zv = acc[ai][1][m][n];
#ifdef V_NODPP
                    f32x4 pg = zg, pv = zv, ng = zg, nv = zv;
#else
                    f32x4 pg = dppz4<0x111>(zg), pv = dppz4<0x111>(zv), ng = dppz4<0x101>(zg), nv = dppz4<0x101>(zv);
                    if (m > 0) { pg += dppz4<0x10F>(acc[ai][0][m - 1][n]); pv += dppz4<0x10F>(acc[ai][1][m - 1][n]); }
                    if (m < 3) { ng += dppz4<0x11F>(acc[ai][0][m + 1][n]); nv += dppz4<0x11F>(acc[ai][1][m + 1][n]); }
#endif
                    const f32x4 cgv = w1g * zg + w0g * pg + w2g * ng + bg, cvv = w1v * zv + w0v * pv + w2v * nv + bv;
                    const int rho = 2 * ai + wr;
#if 0
                    if ((m == 0 && fr == 0) || (m == 3 && fr == 15)) {
                        float* sb = SB + ((size_t)(u.pm * 8 + 2 * rho + (m == 3 ? 1 : 0)) * 4) * 2816 + j0;
                        *(f32x4*)(sb) = zg; *(f32x4*)(sb + 2816) = zv; *(f32x4*)(sb + 2 * 2816) = cgv; *(f32x4*)(sb + 3 * 2816) = cvv;
                    }
#endif
                    const unsigned lo = cvtpk2(silu_f(cgv[0]) * cvv[0], silu_f(cgv[1]) * cvv[1]), hi = cvtpk2(silu_f(cgv[2]) * cvv[2], silu_f(cgv[3]) * cvv[3]);
                    if (n == 0) { pk[ai][m][0] = lo; pk[ai][m][1] = hi; }
                    else { u32x4 w; w.x = pk[ai][m][0]; w.y = pk[ai][m][1]; w.z = lo; w.w = hi;
                        *(u32x4*)(A + (size_t)(u.pm * BM + ai * HALF + wr * 64 + m * 16 + fr) * 2816 + jc) = w; }
                    if (m & 1) { asm volatile("" ::: "memory"); __builtin_amdgcn_sched_barrier(0); }
                }
            }
        }
        if (has_next) { *(PG8_LAS f32x4*)(cwn + v_ * 4) = nextc; asm volatile("s_waitcnt lgkmcnt(0)" ::: "memory"); }
    }
};
#undef CWL

struct TileOrder {
    int nM, nN, nwg, G, c, skip;
    __device__ void init(int nM_, int N, int G_, int c_, int skip_) { nM = nM_; nN = N / BM; nwg = nM * nN; G = G_; c = c_; skip = skip_; }
    __device__ bool next(int i, Unit& u) const {
        const long L = (long)i * G + c; if (L >= nwg) return false;
        int wgid = (int)L; { const int q = nwg / NXCD, r = nwg % NXCD, xcd = wgid % NXCD, off = wgid / NXCD; wgid = (xcd < r ? xcd * (q + 1) : r * (q + 1) + (xcd - r) * q) + off; }
        const int nig = WGM * nN, gid = wgid / nig, fm = gid * WGM, gsz = (nM - fm) < WGM ? (nM - fm) : WGM;
        int pm = fm + ((wgid % nig) % gsz); u.pn = (wgid % nig) / gsz;
        if (skip) pm = (pm >> 3) * 9 + (pm & 7);
        u.pm = pm; return true;
    }
    __device__ __forceinline__ void a_ready(const Unit&) const {}
    __device__ __forceinline__ void done(const Unit&) const {}
};
template <class Epi, class Sched, bool ALIGN_EPI = false, bool SP2 = false>
__device__ __forceinline__ void gemm_phase(PG8_LAS unsigned char* lds, const Gemm g, const Sched& S, const Epi& E) {
    const int tid = opaque_tid(), wid = __builtin_amdgcn_readfirstlane(tid >> 6), lane = tid & 63, wr = wid >> 2, wc = wid & 3, fr = lane & 15, fq = lane >> 4;
    const int K = g.K, nt = K / BK;
    unsigned voffA[2], voffB[2];
#pragma unroll
    for (int i = 0; i < 2; ++i) { int R, C; stage_rc(tid * 16 + i * 8192, R, C); const int Rb = Epi::PERM ? ((R & ~31) + perm32(R & 31)) : R;
        voffA[i] = (unsigned)(R * K + C) * 2u; voffB[i] = (unsigned)(Rb * K + C) * 2u; }
    const size_t kstep = (size_t)(BK * 2);
    const size_t hstep = (size_t)HALF * K * 2;
    const size_t tstep = 2 * hstep;
    const unsigned ldsw = (unsigned)wid * 1024u;
    const int aoff = lds_byte(wr * 64 + fr, fq * 8), boff = lds_byte(wc * 32 + fr, fq * 8);
#define PG8_SA(b, h) (((b) * 2 + (h)) * HTB)
#define PG8_SB(b, h) ((4 + (b) * 2 + (h)) * HTB)
#define PG8_STAGE(bufoff, gbase, voff) do { _Pragma("unroll") for (int _i = 0; _i < 2; ++_i) \
        __builtin_amdgcn_global_load_lds((const unsigned*)((const char*)(gbase) + (voff)[_i]), (PG8_LAS unsigned*)(lds + (bufoff) + ldsw + _i * 8192), 16, 0, 0); } while (0)
#define PG8_LDA(dst, b, h) do { _Pragma("unroll") for (int m = 0; m < 4; ++m) _Pragma("unroll") for (int k = 0; k < 2; ++k) dst[m][k] = *(const PG8_LAS bf16x8*)(lds + PG8_SA(b, h) + aoff + m * 2048 + k * 1024); } while (0)
#define PG8_LDB(dst, b, h) do { _Pragma("unroll") for (int n = 0; n < 2; ++n) _Pragma("unroll") for (int k = 0; k < 2; ++k) dst[n][k] = *(const PG8_LAS bf16x8*)(lds + PG8_SB(b, h) + boff + n * 2048 + k * 1024); } while (0)
#define PG8_MMA(ai, bj, At, Bt) do { __builtin_amdgcn_s_setprio(1); _Pragma("unroll") for (int m = 0; m < 4; ++m) _Pragma("unroll") for (int n = 0; n < 2; ++n) _Pragma("unroll") for (int k = 0; k < 2; ++k) \
        acc[ai][bj][m][n] = __builtin_amdgcn_mfma_f32_16x16x32_bf16(Bt[n][k], At[m][k], acc[ai][bj][m][n], 0, 0, 0); __builtin_amdgcn_s_setprio(0); } while (0)
#define PG8_WAIT_V(n) asm volatile("s_waitcnt vmcnt(" #n ")" ::: "memory")
#define PG8_WAIT_L(n) asm volatile("s_waitcnt lgkmcnt(" #n ")" ::: "memory")
#define PG8_BAR __builtin_amdgcn_s_barrier()
#define PG8_SCHED __builtin_amdgcn_sched_barrier(0)
    Unit cur, nxt; int ui = 0;
    if (!S.next(0, cur)) return;
    f32x4 acc[2][2][4][2];
#pragma unroll
    for (int a = 0; a < 2; ++a)
#pragma unroll
        for (int b = 0; b < 2; ++b)
#pragma unroll
            for (int m = 0; m < 4; ++m)
#pragma unroll
                for (int n = 0; n < 2; ++n) acc[a][b][m][n] = (f32x4){0.f, 0.f, 0.f, 0.f};
    bf16x8 At[4][2], B0[2][2], B1[2][2];
    const char* cA = (const char*)g.A + (size_t)cur.pm * tstep; const char* cB = (const char*)g.Bt + (size_t)cur.pn * tstep;
    S.a_ready(cur);
    if constexpr (SP2) {
        PG8_STAGE(PG8_SB(0, 0), cB, voffB); PG8_STAGE(PG8_SB(0, 1), cB + hstep, voffB); PG8_STAGE(PG8_SA(0, 0), cA, voffA); PG8_STAGE(PG8_SA(0, 1), cA + hstep, voffA);
        if (wr == 1) PG8_BAR;
        PG8_WAIT_V(2); PG8_BAR;
        PG8_STAGE(PG8_SB(1, 0), cB + kstep, voffB); PG8_STAGE(PG8_SA(1, 0), cA + kstep, voffA); PG8_STAGE(PG8_SB(1, 1), cB + hstep + kstep, voffB);
        PG8_WAIT_V(6); PG8_BAR;
    } else {
        PG8_STAGE(PG8_SB(0, 0), cB, voffB); PG8_STAGE(PG8_SA(0, 0), cA, voffA); PG8_STAGE(PG8_SB(0, 1), cB + hstep, voffB); PG8_STAGE(PG8_SA(0, 1), cA + hstep, voffA);
        if (wr == 1) PG8_BAR;
        PG8_WAIT_V(4); PG8_BAR;
        PG8_STAGE(PG8_SB(1, 0), cB + kstep, voffB); PG8_STAGE(PG8_SA(1, 0), cA + kstep, voffA); PG8_STAGE(PG8_SB(1, 1), cB + hstep + kstep, voffB);
        PG8_WAIT_V(6); PG8_BAR;
    }
    for (;;) {
        const bool has_next = S.next(ui + 1, nxt);
        const char* nA = has_next ? (const char*)g.A + (size_t)nxt.pm * tstep : cA; const char* nB = has_next ? (const char*)g.Bt + (size_t)nxt.pn * tstep : cB;
        for (int t = 0; t < nt; t += 2) {
            const bool last = (t == nt - 2);
            const char* a1 = cA + (size_t)(t + 1) * kstep;
            const char* a2 = last ? nA : cA + (size_t)(t + 2) * kstep; const char* b2 = last ? nB : cB + (size_t)(t + 2) * kstep;
            const char* a3 = a2 + kstep; const char* b3 = b2 + kstep;
            if (last && has_next) S.a_ready(nxt);
            if constexpr (SP2) {
            PG8_LDB(B0, 0, 0); PG8_LDB(B1, 0, 1); PG8_SCHED; PG8_LDA(At, 0, 0); PG8_STAGE(PG8_SA(1, 1), a1 + hstep, voffA);
            PG8_WAIT_V(8); PG8_WAIT_L(0); PG8_BAR; PG8_MMA(0, 0, At, B0); PG8_MMA(0, 1, At, B1); PG8_BAR; PG8_SCHED;
            PG8_LDA(At, 0, 1); PG8_STAGE(PG8_SB(0, 0), b2, voffB); PG8_STAGE(PG8_SB(0, 1), b2 + hstep, voffB); PG8_STAGE(PG8_SA(0, 0), a2, voffA);
            PG8_WAIT_V(8); PG8_WAIT_L(0); PG8_BAR; PG8_MMA(1, 0, At, B0); PG8_MMA(1, 1, At, B1); PG8_BAR; PG8_SCHED;
            PG8_LDB(B0, 1, 0); PG8_LDB(B1, 1, 1); PG8_SCHED; PG8_LDA(At, 1, 0); PG8_STAGE(PG8_SA(0, 1), a2 + hstep, voffA);
            PG8_WAIT_V(8); PG8_WAIT_L(0); PG8_BAR; PG8_MMA(0, 0, At, B0); PG8_MMA(0, 1, At, B1); PG8_BAR; PG8_SCHED;
            PG8_LDA(At, 1, 1); PG8_STAGE(PG8_SB(1, 0), b3, voffB); PG8_STAGE(PG8_SB(1, 1), b3 + hstep, voffB); PG8_STAGE(PG8_SA(1, 0), a3, voffA);
            PG8_WAIT_V(8); PG8_WAIT_L(0); PG8_BAR; PG8_MMA(1, 0, At, B0); PG8_MMA(1, 1, At, B1); PG8_BAR; PG8_SCHED;
            } else {
            PG8_LDB(B0, 0, 0); PG8_SCHED; PG8_LDA(At, 0, 0); PG8_STAGE(PG8_SA(1, 1), a1 + hstep, voffA);
            PG8_WAIT_L(8); PG8_BAR; PG8_WAIT_L(0); PG8_MMA(0, 0, At, B0); PG8_BAR; PG8_SCHED;
            PG8_LDB(B1, 0, 1); PG8_STAGE(PG8_SB(0, 0), b2, voffB);
            PG8_BAR; PG8_WAIT_L(0); PG8_MMA(0, 1, At, B1); PG8_BAR;
            PG8_LDA(At, 0, 1); PG8_STAGE(PG8_SA(0, 0), a2, voffA);
            PG8_BAR; PG8_WAIT_L(0); PG8_MMA(1, 0, At, B0); PG8_BAR; PG8_SCHED;
            PG8_STAGE(PG8_SB(0, 1), b2 + hstep, voffB);
            PG8_WAIT_V(6); PG8_BAR; PG8_MMA(1, 1, At, B1); PG8_BAR;
            PG8_LDB(B0, 1, 0); PG8_SCHED; PG8_LDA(At, 1, 0); PG8_STAGE(PG8_SA(0, 1), a2 + hstep, voffA);
            PG8_WAIT_L(8); PG8_BAR; PG8_WAIT_L(0); PG8_MMA(0, 0, At, B0); PG8_BAR; PG8_SCHED;
            PG8_LDB(B1, 1, 1); PG8_STAGE(PG8_SB(1, 0), b3, voffB);
            PG8_BAR; PG8_WAIT_L(0); PG8_MMA(0, 1, At, B1); PG8_BAR;
            PG8_LDA(At, 1, 1); PG8_STAGE(PG8_SA(1, 0), a3, voffA);
            PG8_BAR; PG8_WAIT_L(0); PG8_MMA(1, 0, At, B0); PG8_BAR; PG8_SCHED;
            PG8_STAGE(PG8_SB(1, 1), b3 + hstep, voffB);
            PG8_WAIT_V(6); PG8_BAR; PG8_MMA(1, 1, At, B1); PG8_BAR;
            }
        }
        if constexpr (ALIGN_EPI) { if (wr == 0) PG8_BAR; }
        if constexpr (!Epi::AFTER_DRAIN) { if constexpr (Epi::WANT_NEXT) E(acc, cur, nxt, has_next, ui, wr, wc, fr, fq); else E(acc, cur, wr, wc, fr, fq); S.done(cur); }
        if (!has_next) break;
#pragma unroll
        for (int a = 0; a < 2; ++a)
#pragma unroll
            for (int b = 0; b < 2; ++b)
#pragma unroll
                for (int m = 0; m < 4; ++m)
#pragma unroll
                    for (int n = 0; n < 2; ++n) acc[a][b][m][n] = (f32x4){0.f, 0.f, 0.f, 0.f};
        cur = nxt; cA = nA; cB = nB; ++ui;
        if constexpr (ALIGN_EPI) { if (wr == 1) PG8_BAR; }
    }
    PG8_WAIT_V(0);
    if constexpr (!ALIGN_EPI) { if (wr == 0) PG8_BAR; }
    PG8_BAR;
    if constexpr (Epi::AFTER_DRAIN) { E.fused(acc, cur, wr, wc, fr, fq, lds, wid, lane); S.done(cur); }
#undef PG8_SA
#undef PG8_SB
#undef PG8_STAGE
#undef PG8_LDA
#undef PG8_LDB
#undef PG8_MMA
#undef PG8_WAIT_V
#undef PG8_WAIT_L
#undef PG8_BAR
#undef PG8_SCHED
}
}

#include <hip/hip_bf16.h>
#include <cmath>
namespace attn_body {
using bf16=__hip_bfloat16;
using bf16x8=__attribute__((ext_vector_type(8)))short;
using s16x4=__attribute__((ext_vector_type(4)))short;
using f32x16=__attribute__((ext_vector_type(16)))float;
using u32x4=__attribute__((ext_vector_type(4)))unsigned;
constexpr int D=64,PK=1536,PO=1024;
constexpr int NW=8,QBLK=32,QB=QBLK*NW,KVBLK=64;
constexpr int ATTN_UNIT_ROWS=QB;
__device__ __forceinline__ int crow(int r,int hi){return (r&3)+8*(r>>2)+4*hi;}
#define SBAR() __builtin_amdgcn_sched_barrier(0)
__device__ __forceinline__ void cmask(f32x16&p0,f32x16&p1,int jb,int qrel,int hi){
  const float NEG=-INFINITY; int kb=64*jb+4*hi;
  #pragma unroll
  for(int r=0;r<16;++r){int kv=kb+(r&3)+8*(r>>2); if(kv>qrel)p0[r]=NEG; if(kv+32>qrel)p1[r]=NEG;}
}

constexpr int NSLOT=3, SLOTB=8192;
constexpr int LDS_K=0, LDS_V=NSLOT*SLOTB, LDS_WS=2*NSLOT*SLOTB, LDS_OST=LDS_WS+NW*64*4, LDS_BYTES=LDS_OST+NW*4096;
constexpr float C2=0.125f*1.4426950408889634f;
__device__ __forceinline__ void glds16(const void*gsrc,unsigned lds_dst){unsigned keep;
  asm volatile("s_mov_b32 %0, m0\n\ts_mov_b32 m0, %2\n\ts_nop 0\n\tglobal_load_lds_dwordx4 %1, off\n\ts_mov_b32 m0, %0":"=&s"(keep):"v"(gsrc),"s"(lds_dst):"memory");}
__device__ __forceinline__ float max3f(float a,float b,float c){float r;asm("v_max3_f32 %0, %1, %2, %3":"=v"(r):"v"(a),"v"(b),"v"(c));return r;}
__device__ __forceinline__ float max2f(float a,float b){float r;asm("v_max_f32_e32 %0, %1, %2":"=v"(r):"v"(a),"v"(b));return r;}
__device__ __forceinline__ float fadd_s(float a,float b){float r;asm("v_add_f32_e32 %0, %1, %2":"=v"(r):"v"(a),"v"(b));return r;}
__device__ __forceinline__ float fsub_s(float a,float b){float r;asm("v_sub_f32_e32 %0, %1, %2":"=v"(r):"v"(a),"v"(b));return r;}
typedef float f32x2_t __attribute__((ext_vector_type(2))); typedef __bf16 bf16x2_t __attribute__((ext_vector_type(2)));
__device__ __forceinline__ unsigned cvtpk_s(float lo,float hi){f32x2_t v={lo,hi};bf16x2_t b=__builtin_convertvector(v,bf16x2_t);return __builtin_bit_cast(unsigned,b);}
#define WAIT_BAR(N) asm volatile("s_waitcnt vmcnt(" #N ") lgkmcnt(0)\n\ts_barrier":::"memory")

__device__ __forceinline__ void qkt(f32x16&p0,f32x16&p1,const char*Kslot,const bf16x8*qr,const f32x16&negm,int r32,int hi){
  const char*kb=Kslot+hi*1024+r32*16;
  #pragma unroll
  for(int d0=0;d0<4;++d0){
    const bf16x8 b0=*reinterpret_cast<const bf16x8*>(kb+d0*2048);
    const bf16x8 b1=*reinterpret_cast<const bf16x8*>(kb+d0*2048+512);
    if(d0==0){p0=__builtin_amdgcn_mfma_f32_32x32x16_bf16(b0,qr[0],negm,0,0,0);p1=__builtin_amdgcn_mfma_f32_32x32x16_bf16(b1,qr[0],negm,0,0,0);}
    else{p0=__builtin_amdgcn_mfma_f32_32x32x16_bf16(b0,qr[d0],p0,0,0,0);p1=__builtin_amdgcn_mfma_f32_32x32x16_bf16(b1,qr[d0],p1,0,0,0);}}
}
typedef __attribute__((address_space(3))) const char* lds_cptr;
typedef short v4i16_t __attribute__((ext_vector_type(4)));
__device__ __forceinline__ void kload8(bf16x8*kf,lds_cptr kp){
  kf[0]=*(const __attribute__((address_space(3))) bf16x8*)(kp);      kf[1]=*(const __attribute__((address_space(3))) bf16x8*)(kp+512);
  kf[2]=*(const __attribute__((address_space(3))) bf16x8*)(kp+2048); kf[3]=*(const __attribute__((address_space(3))) bf16x8*)(kp+2560);
  kf[4]=*(const __attribute__((address_space(3))) bf16x8*)(kp+4096); kf[5]=*(const __attribute__((address_space(3))) bf16x8*)(kp+4608);
  kf[6]=*(const __attribute__((address_space(3))) bf16x8*)(kp+6144); kf[7]=*(const __attribute__((address_space(3))) bf16x8*)(kp+6656);
}
__device__ __forceinline__ void kload2(bf16x8*kf,lds_cptr kp,int j){ kf[2*j]=*(const __attribute__((address_space(3))) bf16x8*)(kp+j*2048); kf[2*j+1]=*(const __attribute__((address_space(3))) bf16x8*)(kp+j*2048+512); }
__device__ __forceinline__ s16x4 vtr(lds_cptr p){ return __builtin_bit_cast(s16x4,__builtin_amdgcn_ds_read_tr16_b64_v4i16((__attribute__((address_space(3))) v4i16_t*)p)); }
__device__ __forceinline__ float rowmax(const f32x16&p0,const f32x16&p1){
  float a=max3f(p0[0],p0[1],p1[0]),b=max3f(p0[2],p0[3],p1[1]);a=max3f(a,p1[2],p1[3]);
  #pragma unroll
  for(int r=4;r<16;r+=4){a=max3f(a,p0[r],p0[r+1]);b=max3f(b,p0[r+2],p0[r+3]);a=max3f(a,p1[r],p1[r+1]);b=max3f(b,p1[r+2],p1[r+3]);}
  const float m=max2f(a,b);
  auto rr=__builtin_amdgcn_permlane32_swap(__float_as_uint(m),__float_as_uint(m),false,false);
  return max2f(__uint_as_float(rr[0]),__uint_as_float(rr[1]));
}
__device__ __forceinline__ void pv(f32x16*o,int vb,bf16x8 pa0,bf16x8 pa1,bf16x8 pa2,bf16x8 pa3){
  #pragma unroll
  for(int d0=0;d0<2;++d0){s16x4 lo[4],hi[4];
    #pragma unroll
    for(int ks=0;ks<4;++ks){
      asm volatile("ds_read_b64_tr_b16 %0,%1 offset:%c2":"=&v"(lo[ks]):"v"(vb),"i"(d0*4096+ks*1024):"memory");
      asm volatile("ds_read_b64_tr_b16 %0,%1 offset:%c2":"=&v"(hi[ks]):"v"(vb),"i"(d0*4096+ks*1024+512):"memory");}
    asm volatile("s_waitcnt lgkmcnt(0)":::"memory");SBAR();
    #define PK(k) (bf16x8){lo[k][0],lo[k][1],lo[k][2],lo[k][3],hi[k][0],hi[k][1],hi[k][2],hi[k][3]}
    o[d0]=__builtin_amdgcn_mfma_f32_32x32x16_bf16(pa0,PK(0),o[d0],0,0,0);
    o[d0]=__builtin_amdgcn_mfma_f32_32x32x16_bf16(pa1,PK(1),o[d0],0,0,0);
    o[d0]=__builtin_amdgcn_mfma_f32_32x32x16_bf16(pa2,PK(2),o[d0],0,0,0);
    o[d0]=__builtin_amdgcn_mfma_f32_32x32x16_bf16(pa3,PK(3),o[d0],0,0,0);
    #undef PK
  }
}

#ifndef ATTN_STORE16
#define ATTN_STORE16(p,v) (*(u32x4*)(p)=(v))
#endif
template<int THRL> __device__ __forceinline__ void attn_unit(const bf16*Qu,const bf16*__restrict__ Kh,const bf16*__restrict__ Vh,bf16*Ou,const int NT,char*shm,const float*qgain,const int t0){
  const int tid=pg8::opaque_tid(),lane=tid&63,r32=lane&31,hi=lane>>5; const int wid=__builtin_amdgcn_readfirstlane(tid>>6);
  const bf16*Qw=Qu+(long)(wid*QBLK)*PK;
  const unsigned lds0=(unsigned)(uintptr_t)shm;
  float*wsf=(float*)(shm+LDS_WS)+wid*64;
  const bf16*ksrc=Kh+(long)lane*PK+wid*8;
  const bf16*vsrc=Vh+(long)(16*(wid&3)+(lane>>2))*PK+(wid>>2)*32+(lane&3)*8;
  const unsigned kdst=lds0+LDS_K+wid*1024, vdst=lds0+LDS_V+wid*1024;
  #define DMA_K(t,slot) glds16(ksrc+(long)(t)*KVBLK*PK,(unsigned)__builtin_amdgcn_readfirstlane(kdst+(slot)))
  #define DMA_V(t,slot) glds16(vsrc+(long)(t)*KVBLK*PK,(unsigned)__builtin_amdgcn_readfirstlane(vdst+(slot)))
  const int vb0=(int)(lds0+LDS_V)+((lane>>4)&1)*32+(lane&3)*8+(4*hi+((lane&15)>>2))*64;
  const char*Kbase=shm+LDS_K; bf16x8 kf[8];
  const lds_cptr shm3=(lds_cptr)shm; const lds_cptr kp0=shm3+LDS_K+hi*1024+r32*16; const lds_cptr vp0=shm3+LDS_V+((lane>>4)&1)*32+(lane&3)*8+(4*hi+((lane&15)>>2))*64;
  DMA_K(0,0);DMA_V(0,0);DMA_K(1,SLOTB);
  bf16x8 qr[4];
  #pragma unroll
  for(int d0=0;d0<4;++d0)qr[d0]=*reinterpret_cast<const bf16x8*>(&Qw[(long)r32*PK+d0*16+hi*8]);
  {
    float qv[4][8];
    #pragma unroll
    for(int d0=0;d0<4;++d0){const u32x4 w=__builtin_bit_cast(u32x4,qr[d0]);
      qv[d0][0]=__uint_as_float(w.x<<16);qv[d0][1]=__uint_as_float(w.x&0xffff0000u);qv[d0][2]=__uint_as_float(w.y<<16);qv[d0][3]=__uint_as_float(w.y&0xffff0000u);
      qv[d0][4]=__uint_as_float(w.z<<16);qv[d0][5]=__uint_as_float(w.z&0xffff0000u);qv[d0][6]=__uint_as_float(w.w<<16);qv[d0][7]=__uint_as_float(w.w&0xffff0000u);}
    float ss=0.f;
    #pragma unroll
    for(int d0=0;d0<4;++d0){
      #pragma unroll
      for(int i=0;i<8;++i)ss+=qv[d0][i]*qv[d0][i];}
    {auto rr=__builtin_amdgcn_permlane32_swap(__float_as_uint(ss),__float_as_uint(ss),false,false);ss=__uint_as_float(rr[0])+__uint_as_float(rr[1]);}
    const float rstd=1.0f/sqrtf(ss*(1.0f/64.0f)+1e-6f);
    #pragma unroll
    for(int d0=0;d0<4;++d0){
      #pragma unroll
      for(int i=0;i<8;++i)qv[d0][i]=qv[d0][i]*rstd*qgain[d0*16+hi*8+i];}
    if(t0>=0){const int tq=t0+wid*QBLK+r32;const float rp=(float)(tq>>6),cp=(float)(tq&63);
      #pragma unroll
      for(int i=0;i<8;++i){const float inv=exp2f(-(float)(hi*8+i)*(13.287712379549449f/16.0f));
        {const float a=rp*inv,c=__cosf(a),s=__sinf(a),x1=qv[0][i],x2=qv[1][i];qv[0][i]=x1*c-x2*s;qv[1][i]=x2*c+x1*s;}
        {const float a=cp*inv,c=__cosf(a),s=__sinf(a),x1=qv[2][i],x2=qv[3][i];qv[2][i]=x1*c-x2*s;qv[3][i]=x2*c+x1*s;}}}
    #pragma unroll
    for(int d0=0;d0<4;++d0){u32x4 w;w.x=cvtpk_s(qv[d0][0]*C2,qv[d0][1]*C2);w.y=cvtpk_s(qv[d0][2]*C2,qv[d0][3]*C2);w.z=cvtpk_s(qv[d0][4]*C2,qv[d0][5]*C2);w.w=cvtpk_s(qv[d0][6]*C2,qv[d0][7]*C2);qr[d0]=__builtin_bit_cast(bf16x8,w);}
  }
  float mhat=0.f,l_reg=0.f;f32x16 o[2];o[0]=f32x16{};o[1]=f32x16{};f32x16 negm=f32x16{};asm volatile("":"+v"(negm));
  #define CMASK(P0,P1,t) do{}while(0)
  bool resc=false;
  #define START(P0,P1) do{ const float rm=rowmax(P0,P1); resc=false; \
    { const float dl=rm; mhat=fadd_s(mhat,dl); \
      _Pragma("unroll") for(int r=0;r<16;++r){P0[r]=fsub_s(P0[r],dl);P1[r]=fsub_s(P1[r],dl);} \
      _Pragma("unroll") for(int r=0;r<16;++r)negm[r]=-mhat; asm volatile("":"+v"(negm)); } \
    _Pragma("unroll") for(int r=0;r<16;++r)P0[r]=__builtin_amdgcn_exp2f(P0[r]); }while(0)
  #define RESC() do{ if(resc){ asm volatile("s_waitcnt lgkmcnt(0)":::"memory"); \
      _Pragma("unroll") for(int d_=0;d_<2;++d_) _Pragma("unroll") for(int r=0;r<16;++r)o[d_][r]*=wsf[crow(r,hi)]; } }while(0)
  f32x16 pA0,pA1,pB0,pB1;
  int sl_prev=0,sl_cur=0,sl_next=SLOTB;
  #define ROT() do{sl_prev=sl_cur;sl_cur=sl_next;sl_next=(sl_next==(NSLOT-1)*SLOTB)?0:sl_next+SLOTB;}while(0)
  DMA_K(2,2*SLOTB);
  WAIT_BAR(3);
  qkt(pA0,pA1,Kbase,qr,negm,r32,hi);asm volatile("s_nop 15\n\ts_nop 7":"+v"(pA0),"+v"(pA1));CMASK(pA0,pA1,0);
  START(pA0,pA1);
  _Pragma("unroll") for(int r=0;r<16;++r)pA1[r]=__builtin_amdgcn_exp2f(pA1[r]);
  WAIT_BAR(0);
  DMA_K(3,0);DMA_V(1,SLOTB);
  ROT();
  kload8(kf,kp0+sl_cur);
  WAIT_BAR(2);
  s16x4 vlo[8],vhi[8]; u32x4 pw0,pw1,pw2,pw3;
  #define PKW(P,B) cvtpk_s(P[B],P[B+1])
  #define PAF(k) __builtin_bit_cast(bf16x8,pw##k)
  #define VFR(i) (bf16x8){vlo[i][0],vlo[i][1],vlo[i][2],vlo[i][3],vhi[i][0],vhi[i][1],vhi[i][2],vhi[i][3]}
  #define PIN(x) asm volatile("":"+v"(x))
  #define MX3(a,b,c) __builtin_fmaxf(__builtin_fmaxf((a),(b)),(c))
  #define GAPA(MF,A0,A1,A2,A3,W0,W1,PW) do{ MF; sacc+=A0; sacc+=A1; sacc+=A2; sacc+=A3; PIN(sacc); W0; W1; PIN(PW); SBAR(); }while(0)
  #define EX(v) __builtin_amdgcn_exp2f(v)
  #define GAPB(MF,X,B) do{ MF; X[B]=EX(X[B]); X[B+1]=EX(X[B+1]); X[B+2]=EX(X[B+2]); X[B+3]=EX(X[B+3]); PIN(X); SBAR(); }while(0)
  #define VRD(i) do{ vlo[i]=vtr(vp_+(((i)>>2)*4096+((i)&3)*1024)); vhi[i]=vtr(vp_+(((i)>>2)*4096+((i)&3)*1024+512)); }while(0)
  #define KRD(G,j) do{ if(G){ kload2(kf,kp0+sl_next,j); SBAR(); } }while(0)
  #define STEP(C0,C1,P0,P1,t,GK,GV,GL) do{ SBAR(); \
    const lds_cptr vp_=vp0+sl_prev; \
    VRD(0); SBAR(); float sacc=(P0[0]+P0[1]); \
    GAPA(C0=__builtin_amdgcn_mfma_f32_32x32x16_bf16(kf[0],qr[0],negm,0,0,0), P0[2],P0[3],P0[4],P0[5],     pw0[0]=PKW(P0,0), pw0[1]=PKW(P0,2), pw0); \
    VRD(4); SBAR(); GAPA(C1=__builtin_amdgcn_mfma_f32_32x32x16_bf16(kf[1],qr[0],negm,0,0,0), P0[6],P0[7],P0[8],P0[9],     pw0[2]=PKW(P0,4), pw0[3]=PKW(P0,6), pw0); \
    VRD(1); SBAR(); GAPA(C0=__builtin_amdgcn_mfma_f32_32x32x16_bf16(kf[2],qr[1],C0,0,0,0),   P0[10],P0[11],P0[12],P0[13], pw1[0]=PKW(P0,8), pw1[1]=PKW(P0,10), pw1); \
    VRD(5); SBAR(); GAPA(C1=__builtin_amdgcn_mfma_f32_32x32x16_bf16(kf[3],qr[1],C1,0,0,0),   P0[14],P0[15],P1[0],P1[1],   pw1[2]=PKW(P0,12),pw1[3]=PKW(P0,14), pw1); \
    VRD(2); SBAR(); GAPA(C0=__builtin_amdgcn_mfma_f32_32x32x16_bf16(kf[4],qr[2],C0,0,0,0),   P1[2],P1[3],P1[4],P1[5],     pw2[0]=PKW(P1,0), pw2[1]=PKW(P1,2), pw2); \
    VRD(6); SBAR(); GAPA(C1=__builtin_amdgcn_mfma_f32_32x32x16_bf16(kf[5],qr[2],C1,0,0,0),   P1[6],P1[7],P1[8],P1[9],     pw2[2]=PKW(P1,4), pw2[3]=PKW(P1,6), pw2); \
    VRD(3); SBAR(); GAPA(C0=__builtin_amdgcn_mfma_f32_32x32x16_bf16(kf[6],qr[3],C0,0,0,0),   P1[10],P1[11],P1[12],P1[13], pw3[0]=PKW(P1,8), pw3[1]=PKW(P1,10), pw3); \
    VRD(7); SBAR(); GAPA(C1=__builtin_amdgcn_mfma_f32_32x32x16_bf16(kf[7],qr[3],C1,0,0,0),   P1[14],P1[15],0.f,0.f,       pw3[2]=PKW(P1,12),pw3[3]=PKW(P1,14), pw3); \
    l_reg+=sacc; \
    if(GK){DMA_K((t)+3,sl_cur);} if(GV){DMA_V((t)+1,sl_next);} \
    CMASK(C0,C1,t); \
    { float a=MX3(C0[0],C0[1],C1[0]),b=MX3(C0[2],C0[3],C1[1]); a=MX3(a,C1[2],C1[3]); \
      _Pragma("unroll") for(int r=4;r<16;r+=4){a=MX3(a,C0[r],C0[r+1]);b=MX3(b,C0[r+2],C0[r+3]);a=MX3(a,C1[r],C1[r+1]);b=MX3(b,C1[r+2],C1[r+3]);} \
      float rm=__builtin_fmaxf(a,b); { auto rr=__builtin_amdgcn_permlane32_swap(__float_as_uint(rm),__float_as_uint(rm),false,false); rm=__builtin_fmaxf(__uint_as_float(rr[0]),__uint_as_float(rr[1])); } \
      resc=false; \
      if(__builtin_expect(__any(rm>(float)THRL),0)){ const float dl=__builtin_fmaxf(rm,0.f); mhat+=dl; \
        _Pragma("unroll") for(int r=0;r<16;++r){C0[r]-=dl;C1[r]-=dl;} \
        _Pragma("unroll") for(int r=0;r<16;++r)negm[r]=-mhat; asm volatile("":"+v"(negm)); \
        const float f=__builtin_amdgcn_exp2f(-dl); l_reg*=f; if(hi==0)wsf[r32]=f; resc=true; } } \
    SBAR(); \
    GAPB(o[0]=__builtin_amdgcn_mfma_f32_32x32x16_bf16(PAF(0),VFR(0),o[0],0,0,0), C0,0); \
    GAPB(o[1]=__builtin_amdgcn_mfma_f32_32x32x16_bf16(PAF(0),VFR(4),o[1],0,0,0), C0,4); \
    KRD(GL,0); GAPB(o[0]=__builtin_amdgcn_mfma_f32_32x32x16_bf16(PAF(1),VFR(1),o[0],0,0,0), C0,8); \
    KRD(GL,1); GAPB(o[1]=__builtin_amdgcn_mfma_f32_32x32x16_bf16(PAF(1),VFR(5),o[1],0,0,0), C0,12); \
    KRD(GL,2); GAPB(o[0]=__builtin_amdgcn_mfma_f32_32x32x16_bf16(PAF(2),VFR(2),o[0],0,0,0), C1,0); \
    KRD(GL,3); GAPB(o[1]=__builtin_amdgcn_mfma_f32_32x32x16_bf16(PAF(2),VFR(6),o[1],0,0,0), C1,4); \
    GAPB(o[0]=__builtin_amdgcn_mfma_f32_32x32x16_bf16(PAF(3),VFR(3),o[0],0,0,0), C1,8); \
    GAPB(o[1]=__builtin_amdgcn_mfma_f32_32x32x16_bf16(PAF(3),VFR(7),o[1],0,0,0), C1,12); \
    }while(0)
  int t=1;
  for(;t+5<NT;t+=2){
    STEP(pB0,pB1,pA0,pA1,t,true,true,true);     WAIT_BAR(2); RESC(); ROT();
    STEP(pA0,pA1,pB0,pB1,t+1,true,true,true);   WAIT_BAR(2); RESC(); ROT();
  }
  #define ENDW(tt) do{ if((tt)+3<NT){WAIT_BAR(2);} else if((tt)+2<NT){WAIT_BAR(1);} else {WAIT_BAR(0);} }while(0)
  for(;t+1<NT;t+=2){
    STEP(pB0,pB1,pA0,pA1,t,(t+3<NT),(t+1<NT),(t+1<NT));       ENDW(t);   RESC(); ROT();
    STEP(pA0,pA1,pB0,pB1,t+1,(t+4<NT),(t+2<NT),(t+2<NT));     ENDW(t+1); RESC(); ROT();
  }
  STEP(pB0,pB1,pA0,pA1,NT-1,false,false,false); RESC();
  { float sacc=pB0[0]+pB0[1]; _Pragma("unroll") for(int r=2;r<16;++r)sacc+=pB0[r]; _Pragma("unroll") for(int r=0;r<16;++r)sacc+=pB1[r]; l_reg+=sacc;
    pw0=(u32x4){PKW(pB0,0),PKW(pB0,2),PKW(pB0,4),PKW(pB0,6)};pw1=(u32x4){PKW(pB0,8),PKW(pB0,10),PKW(pB0,12),PKW(pB0,14)};pw2=(u32x4){PKW(pB1,0),PKW(pB1,2),PKW(pB1,4),PKW(pB1,6)};pw3=(u32x4){PKW(pB1,8),PKW(pB1,10),PKW(pB1,12),PKW(pB1,14)};
    SBAR(); pv(o,vb0+sl_cur,PAF(0),PAF(1),PAF(2),PAF(3)); }
  #undef PKW
  #undef PAF
  #undef VFR
  #undef PIN
  #undef MX3
  #undef GAPA
  #undef GAPB
  #undef EX
  #undef VRD
  #undef KRD
  #undef STEP
  #undef ENDW
  {auto rr=__builtin_amdgcn_permlane32_swap(__float_as_uint(l_reg),__float_as_uint(l_reg),false,false);l_reg=__uint_as_float(rr[0])+__uint_as_float(rr[1]);}
  if(hi==0)wsf[32+r32]=l_reg;asm volatile("s_waitcnt lgkmcnt(0)":::"memory");
  float rli[16];
  #pragma unroll
  for(int r=0;r<16;++r)rli[r]=__builtin_amdgcn_rcpf(wsf[32+crow(r,hi)]);
  bf16*Ow=Ou+(long)(wid*QBLK)*PO;
  { bf16*stg=(bf16*)(shm+LDS_OST)+wid*2048;
    #pragma unroll
    for(int r=0;r<16;++r){const int orow=crow(r,hi);
      #pragma unroll
      for(int d0=0;d0<2;++d0)stg[orow*64+d0*32+r32]=__float2bfloat16(o[d0][r]*rli[r]);}
    asm volatile("s_waitcnt lgkmcnt(0)":::"memory");
    #pragma unroll
    for(int i=0;i<4;++i){const int row=i*8+(lane>>3),ch=lane&7; const u32x4 v=*(const u32x4*)(stg+row*64+ch*8); ATTN_STORE16(Ow+(long)row*PO+ch*8,v);} }
  asm volatile("s_waitcnt lgkmcnt(0)\n\ts_barrier":::"memory");
  #undef DMA_K
  #undef DMA_V
  #undef CMASK
  #undef START
  #undef RESC
  #undef ROT
}
constexpr int ATTN_LDS_BYTES=LDS_BYTES;
#undef SBAR
#undef WAIT_BAR
}
constexpr int NB = 32, SEQ = 2048, CTXL = 256, TPB = SEQ + CTXL, MTOK = NB * TPB, DM = 1024, INW = 1536, FF = 2816, FF2 = 5632, MODW = 6144, NLAYER = 2;
constexpr int NTILE = MTOK / 256;
constexpr float EPS = 1e-6f;
constexpr size_t MiB = 1u << 20;
constexpr size_t WS_BAR = 0;
constexpr size_t WS_MOD = 1 * MiB;
constexpr size_t WS_WSB = 3 * MiB;
constexpr size_t WS_WPT = 3 * MiB + 512 * 1024;
constexpr size_t WS_PRM = 3 * MiB + 768 * 1024;
constexpr int PRM_N1G = 0, PRM_N2G = 1024, PRM_QG = 2048, PRM_KG = 2112, PRM_BS = 2176, PRM_PSC = 2688, PRM_CW = 2944, PRM_CB = PRM_CW + 3 * 5632, PRM_L = PRM_CB + 5632;
constexpr size_t WS_WIN = 4 * MiB, WS_WOUT = 10 * MiB, WS_WUP = 14 * MiB, WS_WDN = 36 * MiB;
constexpr size_t WS_SB = 48 * MiB;
constexpr size_t WS_X = 148 * MiB;
constexpr size_t WS_H = 436 * MiB;
constexpr size_t WS_P = 580 * MiB;
constexpr size_t WS_MIX = 796 * MiB;
constexpr size_t WS_A = 580 * MiB;
constexpr size_t WS_END = 976 * MiB;
static_assert(WS_SB + (size_t)NTILE * 8 * 4 * 2816 * 4 <= WS_X && WS_X + (size_t)MTOK * 1024 * 4 <= WS_H && WS_H + (size_t)MTOK * 1024 * 2 <= WS_P && WS_P + (size_t)MTOK * 1536 * 2 <= WS_MIX && WS_MIX + (size_t)MTOK * 1024 * 2 <= WS_END && WS_A + (size_t)MTOK * 2816 * 2 <= WS_END, "d_ws map");
static_assert(WS_WDN + 2 * (size_t)1024 * 2816 * 2 <= WS_SB && WS_WUP + 2 * (size_t)5632 * 1024 * 2 <= WS_WDN && WS_WOUT + 2 * (size_t)1024 * 1024 * 2 <= WS_WUP && WS_WIN + 2 * (size_t)1536 * 1024 * 2 <= WS_WOUT, "weights map");
constexpr int LDS_BYTES = 147584;

#define LAS __attribute__((address_space(3)))
typedef unsigned short bf16;
typedef unsigned v4u __attribute__((ext_vector_type(4)));
typedef unsigned v2u __attribute__((ext_vector_type(2)));
typedef float f32x4 __attribute__((ext_vector_type(4)));
typedef short bf16x8 __attribute__((ext_vector_type(8)));
#define LDS_WAIT() asm volatile("s_waitcnt lgkmcnt(0)" ::: "memory")
__device__ __forceinline__ unsigned pk2(float lo, float hi) { return pg8::cvtpk2(lo, hi); }
__device__ __forceinline__ float bflo(unsigned u) { return __uint_as_float(u << 16); }
__device__ __forceinline__ float bfhi(unsigned u) { return __uint_as_float(u & 0xffff0000u); }
__device__ __forceinline__ float wave_sum(float v) {
#pragma unroll
    for (int o = 1; o < 64; o <<= 1) v += __shfl_xor(v, o);
    return v;
}

__device__ __forceinline__ void p0_transpose_item(const float* W, int K, int N, bf16* WT, bool upperm, LAS float* scr, int item, int lane) {
    const int nblk = N / 32, kb = item / nblk, nb = item % nblk, k0 = 64 * kb, n0 = 32 * nb;
#pragma unroll 8
    for (int i = 0; i < 32; ++i) { const int kk = 2 * i + (lane >> 5); scr[kk * 33 + (lane & 31)] = W[(size_t)(k0 + kk) * N + n0 + (lane & 31)]; }
    LDS_WAIT(); asm volatile("" ::: "memory");
    int r0 = n0;
    if (upperm) { const int j = (n0 < FF) ? n0 : n0 - FF; r0 = 256 * (j >> 7) + (j & 127) + ((n0 < FF) ? 0 : 128); }
    const int c = lane & 7;
#pragma unroll
    for (int j = 0; j < 4; ++j) { const int n = (lane >> 3) + 8 * j; const LAS float* s = scr + (8 * c) * 33 + n;
        v4u o; o.x = pk2(s[0 * 33], s[1 * 33]); o.y = pk2(s[2 * 33], s[3 * 33]); o.z = pk2(s[4 * 33], s[5 * 33]); o.w = pk2(s[6 * 33], s[7 * 33]);
        *(v4u*)(WT + (size_t)(r0 + n) * K + k0 + 8 * c) = o; }
    LDS_WAIT(); asm volatile("" ::: "memory");
}

#define XB_TMO      128
#define XB_XCNT(j)  (256  + 64 * (j))
#define XB_XSUB(j)  (1280 + 64 * (j))
#define XB_XGEN(j)  (2304 + 64 * (j))
#define XB_TOP      3328
#define XB_TOPGEN   3392
#define XCD_BAR_WORDS 3456
#define XB_SPIN_CAP (1u << 18)

__device__ __forceinline__ unsigned xb_ld(unsigned* p)              { return __hip_atomic_load(p, __ATOMIC_RELAXED, __HIP_MEMORY_SCOPE_AGENT); }
__device__ __forceinline__ unsigned xb_add(unsigned* p, unsigned v) { return __hip_atomic_fetch_add(p, v, __ATOMIC_RELAXED, __HIP_MEMORY_SCOPE_AGENT); }
__device__ __forceinline__ unsigned xb_xcc_id() { return (unsigned)__builtin_amdgcn_s_getreg((3 << 11) | 20) & 0xFu; }
#define XB_SPIN(cond, bar) do { unsigned _sp = 0; while (cond) { __builtin_amdgcn_s_sleep(1); \
    if ((++_sp & 255u) == 0u) { if (xb_ld(&(bar)[XB_TMO])) break; if (_sp > XB_SPIN_CAP) { atomicAdd(&(bar)[XB_TMO], 1u); break; } } } } while (0)

struct XcdBarrier {
    unsigned* bar; unsigned x;
    volatile LAS unsigned* st;
};

__device__ __forceinline__ XcdBarrier xcd_barrier_post(unsigned* bar, volatile LAS unsigned* st) {
    XcdBarrier b; b.bar = bar; b.x = xb_xcc_id(); b.st = st;
    if (threadIdx.x == 0) (void)xb_add(&bar[XB_XCNT(b.x)], 1u);
    return b;
}
__device__ __forceinline__ void xcd_barrier_complete(unsigned* bar, unsigned x, unsigned& nloc, unsigned& nx) {
    const unsigned G = gridDim.x * gridDim.y * gridDim.z;
    unsigned sum, cnt, mine, sp = 0u;
    for (;;) {
        sum = 0u; cnt = 0u; mine = 0u;
#pragma unroll
        for (unsigned j = 0; j < 16; ++j) { const unsigned c = xb_ld(&bar[XB_XCNT(j)]); sum += c; cnt += (c > 0u) ? 1u : 0u; mine = (j == x) ? c : mine; }
        if (sum == G) break;
        __builtin_amdgcn_s_sleep(1);
        if ((++sp & 255u) == 0u) { if (xb_ld(&bar[XB_TMO])) break; if (sp > XB_SPIN_CAP) { atomicAdd(&bar[XB_TMO], 1u); break; } }
    }
    nloc = mine > 0u ? mine : 1u; nx = cnt > 0u ? cnt : 1u;
}

__device__ __forceinline__ void xcd_barrier(const XcdBarrier& b) {
    asm volatile("s_waitcnt vmcnt(0)" ::: "memory");
    __syncthreads();
    if (threadIdx.x == 0) {
        unsigned* bar = b.bar;
        __builtin_amdgcn_s_waitcnt(0);
        unsigned nloc = b.st[0], nx = b.st[1];
        if (nloc == 0u) { xcd_barrier_complete(bar, b.x, nloc, nx); b.st[0] = nloc; b.st[1] = nx; }
        const unsigned old = xb_add(&bar[XB_XSUB(b.x)], 1u);
        const unsigned gen = old / nloc;
        if (old + 1u == (gen + 1u) * nloc) {
            __builtin_amdgcn_fence(__ATOMIC_RELEASE, "agent");
            asm volatile("s_waitcnt vmcnt(0)" ::: "memory");
            const unsigned og = xb_add(&bar[XB_TOP], 1u);
            const unsigned tg = og / nx;
            if (og + 1u == (tg + 1u) * nx) xb_add(&bar[XB_TOPGEN], 1u);
            else XB_SPIN(xb_ld(&bar[XB_TOPGEN]) == tg, bar);
            __builtin_amdgcn_fence(__ATOMIC_ACQUIRE, "agent");
            xb_add(&bar[XB_XGEN(b.x)], 1u);
            asm volatile("s_waitcnt vmcnt(0)" ::: "memory");
        } else {
            XB_SPIN(xb_ld(&bar[XB_XGEN(b.x)]) == gen, bar);
            __builtin_amdgcn_fence(__ATOMIC_ACQUIRE, "agent");
            asm volatile("s_waitcnt vmcnt(0)" ::: "memory");
        }
    }
    __syncthreads();
}

struct Args { const float* in[21]; float* out; unsigned char* ws; };

__device__ __forceinline__ void mod_phase(const Args& a, LAS unsigned char* lds, int tid) {
    LAS float* S = (LAS float*)lds;
    LAS float* OUT = (LAS float*)(lds + 33 * 1024 * 4);
    const float* c = a.in[1]; const float* cc = a.in[3]; const float* wmod = a.in[4]; const float* bmod = a.in[5];
    float* MOD = (float*)(a.ws + WS_MOD);
    for (int i = tid; i < 33 * 1024; i += 512) { const int m = i >> 10, k = i & 1023; const float v = (m < 32) ? c[m * 1024 + k] : cc[k]; S[i] = v / (1.0f + __expf(-v)); }
    __syncthreads();
    for (int u = blockIdx.x; u < 384; u += gridDim.x) {
        const int l = u / 192, col0 = (u % 192) * 32;
        for (int i = tid; i < 33 * 32; i += 512) OUT[i] = 0.f;
        __syncthreads();
        const int col = tid & 31, kc = tid >> 5;
        float acc[33];
#pragma unroll
        for (int m = 0; m < 33; ++m) acc[m] = 0.f;
        const float* W = wmod + (size_t)l * 1024 * MODW + col0 + col;
        for (int k4 = 0; k4 < 16; ++k4) {
            const int k = kc * 64 + k4 * 4;
            const float w0 = W[(size_t)(k + 0) * MODW], w1 = W[(size_t)(k + 1) * MODW], w2 = W[(size_t)(k + 2) * MODW], w3 = W[(size_t)(k + 3) * MODW];
#pragma unroll
            for (int m = 0; m < 33; ++m) { const f32x4 s = *(const LAS f32x4*)(S + m * 1024 + k); acc[m] += (s[0] * w0 + s[1] * w1) + (s[2] * w2 + s[3] * w3); }
        }
#pragma unroll
        for (int m = 0; m < 33; ++m) acc[m] += __shfl_xor(acc[m], 32);
        for (int w = 0; w < 8; ++w) {
            if ((tid >> 6) == w && (tid & 63) < 32) {
#pragma unroll
                for (int m = 0; m < 33; ++m) OUT[m * 32 + col] += acc[m];
            }
            __syncthreads();
        }
        for (int i = tid; i < 33 * 32; i += 512) { const int m = i >> 5, q = i & 31; MOD[(size_t)(l * 33 + m) * MODW + col0 + q] = OUT[i] + bmod[l * MODW + col0 + q]; }
        __syncthreads();
    }
}

__device__ __forceinline__ void norm_phase(const float* xin, const float* ctxin, const float* Xb, int from_inputs, const float* gvec, const float* mod, int sh_off, int sc_off,
                                           bf16* H, int skip_ctx, int gw, int NGW, int lane) {
    const int rpw = (MTOK + NGW - 1) / NGW; const int r0 = gw * rpw; int r1 = r0 + rpw; if (r1 > MTOK) r1 = MTOK;
    int cur = -1; f32x4 gs[4], shv[4];
#pragma unroll
    for (int j = 0; j < 4; ++j) { gs[j] = (f32x4){0.f, 0.f, 0.f, 0.f}; shv[j] = gs[j]; }
    for (int r = r0; r < r1; ++r) {
        const int b = r / TPB, t = r - b * TPB; const int midx = (t >= SEQ) ? 32 : b;
        if (skip_ctx && t >= SEQ) continue;
        if (midx != cur) { cur = midx;
#pragma unroll
            for (int j = 0; j < 4; ++j) { const int cidx = 4 * lane + 256 * j; const f32x4 g = *(const f32x4*)(gvec + cidx), sc = *(const f32x4*)(mod + (size_t)midx * MODW + sc_off + cidx);
                gs[j] = g * (sc + 1.0f); shv[j] = *(const f32x4*)(mod + (size_t)midx * MODW + sh_off + cidx); } }
        const float* xr = from_inputs ? (t < SEQ ? xin + ((size_t)b * SEQ + t) * DM : ctxin + ((size_t)b * CTXL + (t - SEQ)) * DM) : Xb + (size_t)r * DM;
        f32x4 v[4]; float ss = 0.f;
#pragma unroll
        for (int j = 0; j < 4; ++j) { v[j] = *(const f32x4*)(xr + 4 * lane + 256 * j); ss += (v[j][0] * v[j][0] + v[j][1] * v[j][1]) + (v[j][2] * v[j][2] + v[j][3] * v[j][3]); }
        const float rstd = 1.0f / sqrtf(wave_sum(ss) * (1.0f / DM) + EPS);
        bf16* hr = H + (size_t)r * DM;
#pragma unroll
        for (int j = 0; j < 4; ++j) { const f32x4 o = v[j] * rstd * gs[j] + shv[j]; v2u w; w.x = pk2(o[0], o[1]); w.y = pk2(o[2], o[3]); *(v2u*)(hr + 4 * lane + 256 * j) = w; }
    }
}
__device__ __forceinline__ void unpack8(v4u r, f32x4& a, f32x4& b) { a = (f32x4){bflo(r.x), bfhi(r.x), bflo(r.y), bfhi(r.y)}; b = (f32x4){bflo(r.z), bfhi(r.z), bflo(r.w), bfhi(r.w)}; }
__device__ __forceinline__ float sq8(const f32x4& a, const f32x4& b) { return ((a[0] * a[0] + a[1] * a[1]) + (a[2] * a[2] + a[3] * a[3])) + ((b[0] * b[0] + b[1] * b[1]) + (b[2] * b[2] + b[3] * b[3])); }
__device__ __forceinline__ void norm_phase_b(const bf16* Xb, const float* gvec, const float* mod, int sh_off, int sc_off, bf16* H, int skip_ctx, int gw, int NGW, int lane) {
    const int rpw = (((MTOK + NGW - 1) / NGW) + 1) & ~1; const int r0 = gw * rpw; int r1 = r0 + rpw; if (r1 > MTOK) r1 = MTOK;
    int cur = -1; f32x4 gs[2][2], shv[2][2];
#pragma unroll
    for (int j = 0; j < 2; ++j) { gs[j][0] = (f32x4){0.f, 0.f, 0.f, 0.f}; gs[j][1] = gs[j][0]; shv[j][0] = gs[j][0]; shv[j][1] = gs[j][0]; }
    for (int r = r0; r < r1; r += 2) {
        const int b = r / TPB, t = r - b * TPB; const int midx = (t >= SEQ) ? 32 : b;
        if (skip_ctx && t >= SEQ) continue;
        if (midx != cur) { cur = midx;
#pragma unroll
            for (int j = 0; j < 2; ++j)
#pragma unroll
                for (int q = 0; q < 2; ++q) { const int cidx = 8 * lane + 512 * j + 4 * q; const f32x4 g = *(const f32x4*)(gvec + cidx), sc = *(const f32x4*)(mod + (size_t)midx * MODW + sc_off + cidx);
                    gs[j][q] = g * (sc + 1.0f); shv[j][q] = *(const f32x4*)(mod + (size_t)midx * MODW + sh_off + cidx); } }
        const bf16* xr = Xb + (size_t)r * DM + 8 * lane;
        const v4u ra0 = *(const v4u*)(xr), ra1 = *(const v4u*)(xr + 512), rb0 = *(const v4u*)(xr + DM), rb1 = *(const v4u*)(xr + DM + 512);
        f32x4 a[2][2], c[2][2];
        unpack8(ra0, a[0][0], a[0][1]); unpack8(ra1, a[1][0], a[1][1]); unpack8(rb0, c[0][0], c[0][1]); unpack8(rb1, c[1][0], c[1][1]);
        float ss0 = sq8(a[0][0], a[0][1]) + sq8(a[1][0], a[1][1]), ss1 = sq8(c[0][0], c[0][1]) + sq8(c[1][0], c[1][1]);
#pragma unroll
        for (int o = 1; o < 64; o <<= 1) { ss0 += __shfl_xor(ss0, o); ss1 += __shfl_xor(ss1, o); }
        const float rstd0 = 1.0f / sqrtf(ss0 * (1.0f / DM) + EPS), rstd1 = 1.0f / sqrtf(ss1 * (1.0f / DM) + EPS);
        bf16* hr = H + (size_t)r * DM + 8 * lane;
#pragma unroll
        for (int j = 0; j < 2; ++j) {
            const f32x4 p0 = a[j][0] * rstd0 * gs[j][0] + shv[j][0], p1 = a[j][1] * rstd0 * gs[j][1] + shv[j][1];
            const f32x4 q0 = c[j][0] * rstd1 * gs[j][0] + shv[j][0], q1 = c[j][1] * rstd1 * gs[j][1] + shv[j][1];
            v4u w0; w0.x = pk2(p0[0], p0[1]); w0.y = pk2(p0[2], p0[3]); w0.z = pk2(p1[0], p1[1]); w0.w = pk2(p1[2], p1[3]); *(v4u*)(hr + 512 * j) = w0;
            v4u w1; w1.x = pk2(q0[0], q0[1]); w1.y = pk2(q0[2], q0[3]); w1.z = pk2(q1[0], q1[1]); w1.w = pk2(q1[2], q1[3]); *(v4u*)(hr + DM + 512 * j) = w1; }
    }
}
__device__ __forceinline__ void final_norm_phase(const bf16* Xb, const float* gvec, float* out, int gw, int NGW, int lane) {
    f32x4 g[2][2];
#pragma unroll
    for (int j = 0; j < 2; ++j)
#pragma unroll
        for (int q = 0; q < 2; ++q) g[j][q] = *(const f32x4*)(gvec + 8 * lane + 512 * j + 4 * q);
    for (int i = gw * 2; i < NB * SEQ; i += NGW * 2) {
        const int b = i / SEQ, t = i - b * SEQ; const bf16* xr = Xb + ((size_t)b * TPB + t) * DM + 8 * lane;
        const v4u ra0 = *(const v4u*)(xr), ra1 = *(const v4u*)(xr + 512), rb0 = *(const v4u*)(xr + DM), rb1 = *(const v4u*)(xr + DM + 512);
        f32x4 a[2][2], c[2][2];
        unpack8(ra0, a[0][0], a[0][1]); unpack8(ra1, a[1][0], a[1][1]); unpack8(rb0, c[0][0], c[0][1]); unpack8(rb1, c[1][0], c[1][1]);
        float ss0 = sq8(a[0][0], a[0][1]) + sq8(a[1][0], a[1][1]), ss1 = sq8(c[0][0], c[0][1]) + sq8(c[1][0], c[1][1]);
#pragma unroll
        for (int o = 1; o < 64; o <<= 1) { ss0 += __shfl_xor(ss0, o); ss1 += __shfl_xor(ss1, o); }
        const float rstd0 = 1.0f / sqrtf(ss0 * (1.0f / DM) + EPS), rstd1 = 1.0f / sqrtf(ss1 * (1.0f / DM) + EPS);
        float* orow = out + (size_t)i * DM + 8 * lane;
#pragma unroll
        for (int j = 0; j < 2; ++j)
#pragma unroll
            for (int q = 0; q < 2; ++q) { *(f32x4*)(orow + 512 * j + 4 * q) = a[j][q] * rstd0 * g[j][q]; *(f32x4*)(orow + DM + 512 * j + 4 * q) = c[j][q] * rstd1 * g[j][q]; }
    }
}

__device__ __forceinline__ v4u normrope8(v4u raw, const float* gain, int s, bool rope, float pos, const float (&invf)[8], float scale) {
    float v[8]; v[0] = bflo(raw.x); v[1] = bfhi(raw.x); v[2] = bflo(raw.y); v[3] = bfhi(raw.y); v[4] = bflo(raw.z); v[5] = bfhi(raw.z); v[6] = bflo(raw.w); v[7] = bfhi(raw.w);
    float ss = 0.f;
#pragma unroll
    for (int i = 0; i < 8; ++i) ss += v[i] * v[i];
    ss += __shfl_xor(ss, 1); ss += __shfl_xor(ss, 2); ss += __shfl_xor(ss, 4);
    const float rstd = 1.0f / sqrtf(ss * (1.0f / 64.0f) + EPS);
    const f32x4 g0 = *(const f32x4*)(gain + 8 * s), g1 = *(const f32x4*)(gain + 8 * s + 4);
    float y[8];
#pragma unroll
    for (int i = 0; i < 4; ++i) { y[i] = v[i] * rstd * g0[i]; y[4 + i] = v[4 + i] * rstd * g1[i]; }
    if (rope) {
#pragma unroll
        for (int i = 0; i < 8; ++i) { const float p = __shfl_xor(y[i], 2); const float ang = pos * invf[i]; const float cs = __cosf(ang), sn = __sinf(ang);
            y[i] = (s & 2) ? (y[i] * cs + p * sn) : (y[i] * cs - p * sn); }
    }
    v4u o; o.x = pk2(y[0] * scale, y[1] * scale); o.y = pk2(y[2] * scale, y[3] * scale); o.z = pk2(y[4] * scale, y[5] * scale); o.w = pk2(y[6] * scale, y[7] * scale);
    return o;
}
constexpr float QSCALE = 0.125f * 1.4426950408889634f;
__device__ __forceinline__ void normrope_phase(bf16* P, const float* kgain, int gw, int NGW, int lane) {
    const int s = lane & 7, q = lane >> 4, piece = lane & 15;
    float invf[8];
#pragma unroll
    for (int i = 0; i < 8; ++i) invf[i] = exp2f(-(float)(8 * (s & 1) + i) * (13.287712379549449f / 16.0f));
    const int rpw = (((MTOK + NGW - 1) / NGW) + 11) / 12 * 12; const int r0 = gw * rpw; int r1 = r0 + rpw; if (r1 > MTOK) r1 = MTOK;
    for (int r = r0; r < r1; r += 12) {
        v4u rk[3];
#pragma unroll
        for (int g = 0; g < 3; ++g) rk[g] = *(const v4u*)(P + (size_t)(r + 4 * g + q) * INW + 512 + 8 * piece);
#pragma unroll
        for (int g = 0; g < 3; ++g) {
            const int rr = r + 4 * g; const int b = rr / TPB, t = rr - b * TPB + q; const bool rope = t < SEQ;
            const float pos = (s < 4) ? (float)(t >> 6) : (float)(t & 63);
            *(v4u*)(P + (size_t)(rr + q) * INW + 512 + 8 * piece) = normrope8(rk[g], kgain, s, rope, pos, invf, 1.0f);
        }
    }
}

__device__ __forceinline__ void sgu_phase(const bf16* P, bf16* MIX, const bf16* Wsb  , const float* bs  , LAS unsigned char* lds, int wave, int gw, int NGW, int lane) {
    LAS unsigned short* vT = (LAS unsigned short*)(lds + wave * 17408);
    const int fr = lane & 15, fq = lane >> 4;
    for (int unit = gw; unit < (MTOK / 128) * 4; unit += NGW) {
        const int cidx = unit >> 2, g = unit & 3; const size_t row0 = (size_t)cidx * 128;
        v4u rawv[16];
#pragma unroll
        for (int it = 0; it < 16; ++it) { const int idx = it * 64 + lane, q = idx >> 3, pc = idx & 7; rawv[it] = *(const v4u*)(P + (row0 + q) * INW + 1024 + 64 * g + 8 * pc); }
#pragma unroll
        for (int it = 0; it < 16; ++it) { const int idx = it * 64 + lane, q = idx >> 3, pc = idx & 7;
            const v4u raw = rawv[it];
            LAS unsigned short* dst = vT + (8 * pc) * 136 + q;
            dst[0 * 136] = (unsigned short)(raw.x & 0xffffu); dst[1 * 136] = (unsigned short)(raw.x >> 16); dst[2 * 136] = (unsigned short)(raw.y & 0xffffu); dst[3 * 136] = (unsigned short)(raw.y >> 16);
            dst[4 * 136] = (unsigned short)(raw.z & 0xffffu); dst[5 * 136] = (unsigned short)(raw.z >> 16); dst[6 * 136] = (unsigned short)(raw.w & 0xffffu); dst[7 * 136] = (unsigned short)(raw.w >> 16); }
        LDS_WAIT(); asm volatile("" ::: "memory");
#pragma unroll 1
        for (int ph = 0; ph < 2; ++ph) {
            f32x4 acc[4][4];
#pragma unroll
            for (int pb = 0; pb < 4; ++pb)
#pragma unroll
                for (int db = 0; db < 4; ++db) acc[pb][db] = (f32x4){0.f, 0.f, 0.f, 0.f};
#pragma unroll
            for (int kq = 0; kq < 4; ++kq) {
                bf16x8 af[4], bfr[4];
#pragma unroll
                for (int db = 0; db < 4; ++db) af[db] = *(const LAS bf16x8*)(vT + (16 * db + fr) * 136 + 32 * kq + 8 * fq);
#pragma unroll
                for (int pb = 0; pb < 4; ++pb) bfr[pb] = *(const bf16x8*)(Wsb + (size_t)(g * 128 + 64 * ph + 16 * pb + fr) * 128 + 32 * kq + 8 * fq);
#pragma unroll
                for (int pb = 0; pb < 4; ++pb)
#pragma unroll
                    for (int db = 0; db < 4; ++db) acc[pb][db] = __builtin_amdgcn_mfma_f32_16x16x32_bf16(af[db], bfr[pb], acc[pb][db], 0, 0, 0);
            }
#pragma unroll
            for (int pb = 0; pb < 4; ++pb) { const int p = 64 * ph + 16 * pb + fr; const float bias = bs[g * 128 + p]; const size_t row = row0 + p;
#pragma unroll
                for (int db = 0; db < 4; ++db) { const int d = 16 * db + 4 * fq; const v2u uu = *(const v2u*)(P + row * INW + 768 + 64 * g + d);
                    v2u o; o.x = pk2(bflo(uu.x) * (acc[pb][db][0] + bias), bfhi(uu.x) * (acc[pb][db][1] + bias)); o.y = pk2(bflo(uu.y) * (acc[pb][db][2] + bias), bfhi(uu.y) * (acc[pb][db][3] + bias));
                    *(v2u*)(MIX + row * DM + 512 + 64 * g + d) = o; } }
        }
        LDS_WAIT(); asm volatile("" ::: "memory");
    }
}

__device__ __forceinline__ void pool_phase(const bf16* P, bf16* MIX, const bf16* WpT  , const float* pscale  , LAS unsigned char* lds, int wave, int gw, int NGW, int lane) {
    const int fr = lane & 15, fq = lane >> 4;
    LAS unsigned char* img = lds + wave * 16896;
    for (int tb = gw; tb < MTOK / 16; tb += NGW) {
        const int r0 = tb * 16; const int b = r0 / TPB, t0 = r0 - b * TPB; const int tt0 = (t0 < SEQ) ? t0 : t0 - SEQ, L = (t0 < SEQ) ? SEQ : CTXL;
        const bf16* seg = P + (size_t)(r0 - tt0) * INW + 1280;
#pragma unroll
        for (int it = 0; it < 16; ++it) { const int idx = it * 64 + lane, row = idx >> 5, pc = idx & 31;
            int tp = tt0 - 8 + row; tp = tp < 0 ? 0 : (tp > L - 1 ? L - 1 : tp);
            *(LAS v4u*)(img + row * 528 + pc * 16) = *(const v4u*)(seg + (size_t)tp * INW + 8 * pc); }
        LDS_WAIT(); asm volatile("" ::: "memory");
        const int tt = tt0 + fr; const int r = r0 + fr;
#pragma unroll 1
        for (int gi = 0; gi < 4; ++gi) {
            const int w = 2 << gi, left = w >> 1, right = w - 1 - left;
            int lo = tt - left; if (lo < 0) lo = 0; int hi = tt + right; if (hi > L - 1) hi = L - 1;
            const float rc = 1.0f / (float)(hi - lo + 1);
            bf16x8 yf[2];
#pragma unroll
            for (int ks = 0; ks < 2; ++ks) {
                const LAS unsigned char* src = img + (64 * gi + 32 * ks + 8 * fq) * 2;
                float sum[8];
#pragma unroll
                for (int i = 0; i < 8; ++i) sum[i] = 0.f;
                for (int tp = lo; tp <= hi; ++tp) { const v4u raw = *(const LAS v4u*)(src + (tp - tt0 + 8) * 528);
                    sum[0] += bflo(raw.x); sum[1] += bfhi(raw.x); sum[2] += bflo(raw.y); sum[3] += bfhi(raw.y); sum[4] += bflo(raw.z); sum[5] += bfhi(raw.z); sum[6] += bflo(raw.w); sum[7] += bfhi(raw.w); }
                const v4u own = *(const LAS v4u*)(src + (fr + 8) * 528);
                v4u pkd; pkd.x = pk2(sum[0] * rc - bflo(own.x), sum[1] * rc - bfhi(own.x)); pkd.y = pk2(sum[2] * rc - bflo(own.y), sum[3] * rc - bfhi(own.y));
                pkd.z = pk2(sum[4] * rc - bflo(own.z), sum[5] * rc - bfhi(own.z)); pkd.w = pk2(sum[6] * rc - bflo(own.w), sum[7] * rc - bfhi(own.w));
                yf[ks] = __builtin_bit_cast(bf16x8, pkd);
            }
#pragma unroll
            for (int eb = 0; eb < 4; ++eb) {
                f32x4 acc = (f32x4){0.f, 0.f, 0.f, 0.f};
#pragma unroll
                for (int ks = 0; ks < 2; ++ks) { const bf16x8 af = *(const bf16x8*)(WpT + (size_t)(gi * 64 + 16 * eb + fr) * 64 + 32 * ks + 8 * fq); acc = __builtin_amdgcn_mfma_f32_16x16x32_bf16(af, yf[ks], acc, 0, 0, 0); }
                const int e = 16 * eb + 4 * fq; const f32x4 psc = *(const f32x4*)(pscale + 64 * gi + e);
                v2u o; o.x = pk2(acc[0] * psc[0], acc[1] * psc[1]); o.y = pk2(acc[2] * psc[2], acc[3] * psc[3]);
                *(v2u*)(MIX + (size_t)r * DM + 768 + 64 * gi + e) = o;
            }
        }
        LDS_WAIT(); asm volatile("" ::: "memory");
    }
}

__device__ __forceinline__ void fixup_phase(bf16* A, const float* SB, const float* cw, int skip_ctx, int gw, int NGW, int lane) {
    for (int item = gw; item < NTILE * 8; item += NGW) {
        const int pm = item >> 3, e = item & 7; const int b = pm / 9, j = pm - 9 * b;
        if (skip_ctx && j == 8) continue;
        int npm = -1, ne = 0;
        if ((e & 1) == 0) { if (e > 0) { npm = pm; ne = e - 1; } else if (j >= 1 && j <= 7) { npm = pm - 1; ne = 7; } }
        else { if (e < 7) { npm = pm; ne = e + 1; } else if (j <= 6) { npm = pm + 1; ne = 0; } }
        if (npm < 0) continue;
        const float* own = SB + (size_t)(pm * 8 + e) * 4 * 2816; const float* nbr = SB + (size_t)(npm * 8 + ne) * 4 * 2816;
        const float* wt = cw + ((e & 1) ? 2 * FF2 : 0);
        bf16* arow = A + (size_t)(pm * 256 + 64 * (e >> 1) + ((e & 1) ? 63 : 0)) * FF;
#pragma unroll 4
        for (int i = lane; i < FF / 4; i += 64) { const int jj = 4 * i;
            const f32x4 zg = *(const f32x4*)(own + 2 * 2816 + jj) + *(const f32x4*)(wt + jj) * *(const f32x4*)(nbr + jj);
            const f32x4 zv = *(const f32x4*)(own + 3 * 2816 + jj) + *(const f32x4*)(wt + FF + jj) * *(const f32x4*)(nbr + 2816 + jj);
            v2u o; o.x = pk2(pg8::silu_f(zg[0]) * zv[0], pg8::silu_f(zg[1]) * zv[1]); o.y = pk2(pg8::silu_f(zg[2]) * zv[2], pg8::silu_f(zg[3]) * zv[3]);
            *(v2u*)(arow + jj) = o; }
    }
}
#ifndef REP_LIGHT
#define REP_LIGHT 1
#endif
#ifndef REP_ATTN
#define REP_ATTN 1
#endif
#ifndef REP_SYNC
#define REP_SYNC 1
#endif
__global__ void __launch_bounds__(512, 2) mk_fwd(Args args) {
    extern __shared__ __attribute__((aligned(16))) unsigned char lds[];
    cg::grid_group grid = cg::this_grid();
    LAS unsigned char* l3 = (LAS unsigned char*)lds;
    int tid = pg8::opaque_tid(), lane = tid & 63, wave = __builtin_amdgcn_readfirstlane(tid >> 6);
    const int G = gridDim.x, bx = blockIdx.x;
    const int vcu = (G % 8 == 0) ? (bx % 8) * (G / 8) + bx / 8 : bx;
    int gw = vcu * 8 + wave; const int NGW = G * 8;
    unsigned char* ws = args.ws;
#define RELAUNDER() do { ws = args.ws; asm volatile("" : "+s"(ws)); tid = pg8::opaque_tid(); lane = tid & 63; wave = __builtin_amdgcn_readfirstlane(tid >> 6); gw = vcu * 8 + wave; } while (0)
    float* PRM = (float*)(ws + WS_PRM);
#define GSYNC() do { for (int rs_ = 0; rs_ < REP_SYNC; ++rs_) xcd_barrier(xbar); RELAUNDER(); } while (0)
#define MOD ((float*)(ws + WS_MOD))
#define WSB ((bf16*)(ws + WS_WSB))
#define WPT ((bf16*)(ws + WS_WPT))
#define SB ((float*)(ws + WS_SB))
#define X ((bf16*)(ws + WS_X))
#define H ((bf16*)(ws + WS_H))
#define P ((bf16*)(ws + WS_P))
#define MIX ((bf16*)(ws + WS_MIX))
#define A ((bf16*)(ws + WS_A))
#define x_in (args.in[0])
#define ctx_in (args.in[2])
#define PRML ((const float*)(ws + WS_PRM) + (size_t)l * PRM_L)

    if (bx == 0) for (int i = tid; i < XCD_BAR_WORDS; i += 512) ((unsigned*)(ws + WS_BAR))[i] = 0u;
    if (tid < 2) ((volatile LAS unsigned*)(l3 + LDS_BYTES - 64))[tid] = 0u;
    __syncthreads();
#if !defined(ONLY) || ONLY==1
    mod_phase(args, l3, tid);
#endif

    {
        LAS float* scr = (LAS float*)(l3 + wave * 16384);
        constexpr int I_IN = 16 * 48, I_OUT = 16 * 32, I_UP = 16 * 176, I_DN = 44 * 32, I_L = I_IN + I_OUT + I_UP + I_DN;
        for (int it = gw; it < NLAYER * I_L; it += NGW) {
            const int l = it / I_L; int r = it - l * I_L;
            if (r < I_IN) { p0_transpose_item(args.in[7] + (size_t)l * DM * INW, DM, INW, (bf16*)(ws + WS_WIN) + (size_t)l * INW * DM, false, scr, r, lane); continue; } r -= I_IN;
            if (r < I_OUT) { p0_transpose_item(args.in[14] + (size_t)l * DM * DM, DM, DM, (bf16*)(ws + WS_WOUT) + (size_t)l * DM * DM, false, scr, r, lane); continue; } r -= I_OUT;
            if (r < I_UP) { p0_transpose_item(args.in[16] + (size_t)l * DM * FF2, DM, FF2, (bf16*)(ws + WS_WUP) + (size_t)l * FF2 * DM, true, scr, r, lane); continue; } r -= I_UP;
            p0_transpose_item(args.in[19] + (size_t)l * FF * DM, FF, DM, (bf16*)(ws + WS_WDN) + (size_t)l * DM * FF, false, scr, r, lane);
        }
        const int gt = gw * 64 + lane, NGT = NGW * 64;
        for (int l = 0; l < NLAYER; ++l) { float* pl = PRM + (size_t)l * PRM_L;
            for (int i = gt; i < 1024; i += NGT) { pl[PRM_N1G + i] = args.in[6][l * 1024 + i]; pl[PRM_N2G + i] = args.in[15][l * 1024 + i]; }
            for (int i = gt; i < 64; i += NGT) { pl[PRM_QG + i] = args.in[8][l * 64 + i]; pl[PRM_KG + i] = args.in[9][l * 64 + i]; }
            for (int i = gt; i < 512; i += NGT) pl[PRM_BS + i] = args.in[11][l * 512 + i];
            for (int i = gt; i < 256; i += NGT) pl[PRM_PSC + i] = args.in[13][l * 256 + i];
            for (int i = gt; i < 3 * FF2; i += NGT) pl[PRM_CW + i] = args.in[17][(size_t)l * 3 * FF2 + i];
            for (int i = gt; i < FF2; i += NGT) pl[PRM_CB + i] = args.in[18][(size_t)l * FF2 + i]; }
        for (int i = gt; i < 1024; i += NGT) PRM[NLAYER * PRM_L + i] = args.in[20][i];
        for (int i = gt; i < NLAYER * 4 * 128 * 128; i += NGT) WSB[i] = (bf16)(pk2(args.in[10][i], 0.f) & 0xffffu);
        for (int i = gt; i < NLAYER * 4 * 64 * 64; i += NGT) { const int d = i & 63, e = (i >> 6) & 63, lg = i >> 12; WPT[i] = (bf16)(pk2(args.in[12][(size_t)lg * 4096 + d * 64 + e], 0.f) & 0xffffu); }
    }
    grid.sync(); RELAUNDER();
    XcdBarrier xbar = xcd_barrier_post((unsigned*)(ws + WS_BAR), (volatile LAS unsigned*)(l3 + LDS_BYTES - 64));

    for (int l = 0; l < NLAYER; ++l) {
        const int last = (l == NLAYER - 1);
#define mod (MOD + (size_t)l * 33 * MODW)
#define Win_t ((const bf16*)(ws + WS_WIN) + (size_t)l * INW * DM)
#define Wout_t ((const bf16*)(ws + WS_WOUT) + (size_t)l * DM * DM)
#define Wup_t ((const bf16*)(ws + WS_WUP) + (size_t)l * FF2 * DM)
#define Wdn_t ((const bf16*)(ws + WS_WDN) + (size_t)l * DM * FF)
#if !defined(ONLY) || ONLY==2
        for (int rep_ = 0; rep_ < REP_LIGHT; ++rep_)
        if (l == 0) norm_phase(x_in, ctx_in, nullptr, 1, PRML + PRM_N1G, mod, 0, 1024, H, 0, gw, NGW, lane);
        else norm_phase_b(X, PRML + PRM_N1G, mod, 0, 1024, H, 0, gw, NGW, lane);
#endif

        GSYNC();
#if !defined(ONLY) || ONLY==3
        { pg8::Gemm g{H, Win_t, MTOK, INW, DM}; pg8::TileOrder S; S.init(NTILE, INW, G, bx, 0);
          pg8::EpiBf16<0> E{P, INW, nullptr, 0, 0, 1.f};
          pg8::gemm_phase<pg8::EpiBf16<0>, pg8::TileOrder, true, true>(l3, g, S, E); }
#endif

        GSYNC();
#if !defined(ONLY) || ONLY==4
        normrope_phase(P, PRML + PRM_KG, gw, NGW, lane);
#endif

#if !defined(ONLY) || ONLY==5
        for (int rep_ = 0; rep_ < REP_LIGHT; ++rep_) {
        sgu_phase(P, MIX, WSB + (size_t)l * 4 * 128 * 128, PRML + PRM_BS, l3, wave, gw, NGW, lane);
#endif

#if !defined(ONLY) || ONLY==6
        pool_phase(P, MIX, WPT + (size_t)l * 4 * 64 * 64, PRML + PRM_PSC, l3, wave, gw, NGW, lane); }
#endif

        GSYNC();
        {
#if !defined(ONLY) || ONLY==7
            for (int rep_ = 0; rep_ < REP_ATTN; ++rep_)
            for (int bh = vcu; bh < NB * 8; bh += G) {
                const int b = bh >> 3, h = bh & 7;
                const attn_body::bf16* Pb = (const attn_body::bf16*)P + (size_t)b * TPB * INW;
                attn_body::bf16* Ob = (attn_body::bf16*)MIX + (size_t)b * TPB * DM + h * 64;
                const attn_body::bf16* Kb = Pb + 512 + (h >> 2) * 64; const attn_body::bf16* Vb = Pb + 640 + (h >> 2) * 64;
                const int nu = last ? 8 : 9;
                for (int qb = 0; qb < nu; ++qb) {
                    const attn_body::bf16* Qu = Pb + (size_t)(qb * 256) * INW + h * 64;
                    if (qb < 8) attn_body::attn_unit<8>(Qu, Kb, Vb, Ob + (size_t)(qb * 256) * DM, (SEQ + CTXL) / 64, (char*)lds, PRML + PRM_QG, qb * 256);
                    else attn_body::attn_unit<8>(Qu, Kb + (size_t)SEQ * INW, Vb + (size_t)SEQ * INW, Ob + (size_t)(qb * 256) * DM, CTXL / 64, (char*)lds, PRML + PRM_QG, -1);
                }
            }
#endif

        }
        GSYNC();
#if !defined(ONLY) || ONLY==8
        { pg8::Gemm g{MIX, Wout_t, MTOK, DM, DM}; pg8::TileOrder S; S.init(last ? NB * 8 : NTILE, DM, G, bx, last);
          pg8::EpiRes E{x_in, ctx_in, X, mod + 2048, l == 0};
          pg8::gemm_phase<pg8::EpiRes, pg8::TileOrder, true, true>(l3, g, S, E); }
#endif

        GSYNC();
        for (int rep_ = 0; rep_ < REP_LIGHT; ++rep_)
        norm_phase_b(X, PRML + PRM_N2G, mod, 3072, 4096, H, last, gw, NGW, lane);
        GSYNC();
#if !defined(ONLY) || ONLY==9
        { pg8::Gemm g{H, Wup_t, MTOK, FF2, DM}; pg8::TileOrder S; S.init(last ? NB * 8 : NTILE, FF2, G, bx, last);
          pg8::EpiUpGate E{A, SB, PRML + PRM_CW, PRML + PRM_CB, (LAS float*)(l3 + 131072)};
          pg8::gemm_phase<pg8::EpiUpGate, pg8::TileOrder, true, true>(l3, g, S, E); }
#endif

        GSYNC();
#if !defined(ONLY) || ONLY==10
        for (int rep_ = 0; rep_ < REP_LIGHT; ++rep_)
        fixup_phase(A, SB, PRML + PRM_CW, last, gw, NGW, lane);
#endif

        GSYNC();
#if !defined(ONLY) || ONLY==11
        { pg8::Gemm g{A, Wdn_t, MTOK, DM, FF}; pg8::TileOrder S; S.init(last ? NB * 8 : NTILE, DM, G, bx, last);
          pg8::EpiRes E{x_in, ctx_in, X, mod + 5120, 0};
          pg8::gemm_phase<pg8::EpiRes, pg8::TileOrder, true, true>(l3, g, S, E); }
#endif

        GSYNC();
    }
    for (int rep_ = 0; rep_ < REP_LIGHT; ++rep_)
    final_norm_phase(X, (const float*)(ws + WS_PRM) + NLAYER * PRM_L, args.out, gw, NGW, lane);
}

extern "C" void kernel_launch(void* const* d_in, const int* in_sizes, int n_in, void* d_out, int out_size, void* d_ws, size_t ws_size, hipStream_t stream) {
    static int grid = 0;
    if (grid == 0) {
        if (n_in != 21 || in_sizes[0] != NB * SEQ * DM || out_size != NB * SEQ * DM || ws_size < WS_END) { fprintf(stderr, "kernel_launch: unexpected shapes (n_in %d, in0 %d, out %d, ws %zu); nothing launched\n", n_in, n_in > 0 ? in_sizes[0] : -1, out_size, ws_size); grid = -1; return; }
        int dev = 0, cus = 0, per_cu = 0;
        if (hipGetDevice(&dev) != hipSuccess || hipDeviceGetAttribute(&cus, hipDeviceAttributeMultiprocessorCount, dev) != hipSuccess) { grid = -1; return; }
        if (hipFuncSetAttribute((const void*)mk_fwd, hipFuncAttributeMaxDynamicSharedMemorySize, LDS_BYTES) != hipSuccess) { fprintf(stderr, "kernel_launch: hipFuncSetAttribute failed\n"); grid = -1; return; }
        if (hipOccupancyMaxActiveBlocksPerMultiprocessor(&per_cu, (const void*)mk_fwd, 512, LDS_BYTES) != hipSuccess || per_cu < 1) { fprintf(stderr, "kernel_launch: occupancy query says %d\n", per_cu); per_cu = 1; }
        (void)hipGetLastError();
        grid = cus * 1;
    }
    if (grid < 0) return;
    Args a{};
    for (int i = 0; i < 21; ++i) a.in[i] = (const float*)d_in[i];
    a.out = (float*)d_out; a.ws = (unsigned char*)d_ws;
    void* kargs[] = {&a};
    hipError_t e = hipLaunchCooperativeKernel((const void*)mk_fwd, dim3(grid), dim3(512), kargs, LDS_BYTES, stream);
    if (e != hipSuccess) fprintf(stderr, "cooperative launch failed: %s (grid %d)\n", hipGetErrorString(e), grid);
}
```

```cpp
#include <hip/hip_runtime.h>
#include <hip/hip_cooperative_groups.h>
#include <hip/hip_bf16.h>
#include <cstdio>
#include <cstdint>
#include <cmath>
namespace cg = cooperative_groups;
namespace pg8 { __device__ __forceinline__ int opaque_tid() { int t = threadIdx.x; asm volatile("" : "+v"(t)); return t; } }
namespace pg8 {
#define PG8_LAS __attribute__((address_space(3)))
typedef unsigned short bf16_t;
typedef short bf16x8 __attribute__((ext_vector_type(8)));
typedef float f32x4 __attribute__((ext_vector_type(4)));
typedef unsigned u32x4 __attribute__((ext_vector_type(4)));
constexpr int BM = 256, BK = 64, HALF = 128, HTB = HALF * BK * 2  , STAGE_BYTES = 8 * HTB, NXCD = 8, WGM = 4;

__host__ __device__ __forceinline__ int lds_byte(int r, int c) { const int st = (r >> 4) * 2 + (c >> 5), rr = r & 15, cc = c & 31, ob = rr * 64 + cc * 2; return st * 1024 + (ob ^ (((ob >> 9) & 1) << 5)); }
__host__ __device__ __forceinline__ void stage_rc(int b, int& R, int& C) { const int st = b / 1024, sb = b % 1024, swz = sb ^ (((sb >> 9) & 1) << 5); R = (st >> 1) * 16 + swz / 64; C = (st & 1) * 32 + (swz % 64) / 2; }
__host__ __device__ __forceinline__ int perm32(int rho) { const int n = rho >> 4, i = rho & 15; return 8 * (i >> 2) + 4 * n + (i & 3); }

struct Unit { int pm, pn; };
struct Gemm { const bf16_t* A; const bf16_t* Bt; int M, N, K; };

struct StaticOrder {
    int nM, nN, nwg, G, c;
    __host__ __device__ void init(int M, int N, int G_, int c_) { nM = M / BM; nN = N / BM; nwg = nM * nN; G = G_; c = c_; }
    __host__ __device__ bool next(int i, Unit& u) const {
        const long L = (long)i * G + c; if (L >= nwg) return false;
        int wgid = (int)L; { const int q = nwg / NXCD, r = nwg % NXCD, xcd = wgid % NXCD, off = wgid / NXCD; wgid = (xcd < r ? xcd * (q + 1) : r * (q + 1) + (xcd - r) * q) + off; }
        const int nig = WGM * nN, gid = wgid / nig, fm = gid * WGM, gsz = (nM - fm) < WGM ? (nM - fm) : WGM;
        u.pm = fm + ((wgid % nig) % gsz); u.pn = (wgid % nig) / gsz; return true;
    }
    __device__ __forceinline__ void a_ready(const Unit&) const {}
    __device__ __forceinline__ void done(const Unit&) const {}
};

__device__ __forceinline__ unsigned cvt_pk_bf16(float lo, float hi) { unsigned r; asm volatile("v_cvt_pk_bf16_f32 %0, %1, %2" : "=v"(r) : "v"(lo), "v"(hi)); return r; }
typedef float f32x2 __attribute__((ext_vector_type(2)));
__device__ __forceinline__ f32x2 gelu_pk(f32x2 v) {
    const f32x2 av = __builtin_elementwise_abs(v), d = av * 0.2316418882f + 1.0f;
    f32x2 t; t.x = __builtin_amdgcn_rcpf(d.x); t.y = __builtin_amdgcn_rcpf(d.y);
    f32x2 q = t * 0.5307027145f + (-0.7265760135f); q = q * t + 0.7107068705f; q = q * t + (-0.142248368f); q = q * t + 0.127414796f; q = q * t;
    const f32x2 s = (v * v) * (-0.72134752044f);
    f32x2 e; e.x = __builtin_amdgcn_exp2f(s.x); e.y = __builtin_amdgcn_exp2f(s.y);
    const f32x2 m = v * (q * e), r = v - m;
    f32x2 o; o.x = v.x < 0.f ? m.x : r.x; o.y = v.y < 0.f ? m.y : r.y; return o;
}

template <int ACT  > struct EpiBf16 {
    static constexpr bool PERM = true, AFTER_DRAIN = false; static_assert(ACT == 0 || ACT == 1, "EpiBf16: ACT is 0 (none) or 1 (gelu_pk)");
    bf16_t* O; int ldc; const float* bias; int split_cols; size_t split_stride; float scale0;
    __device__ __forceinline__ void operator()(const f32x4 (&acc)[2][2][4][2], const Unit& u, int wr, int wc, int fr, int fq) const {
        const int row0 = u.pm * BM + wr * 64 + fr; int colt = u.pn * BM; bf16_t* base = O;
        float sc = 1.f; if (split_cols) { const int t = colt / split_cols; base += (size_t)t * split_stride; colt -= t * split_cols; if (t == 0) sc = scale0; }
        const int col0 = colt + wc * 32 + 8 * fq, bcol0 = u.pn * BM + wc * 32 + 8 * fq;
        f32x4 bv[2][2];
#pragma unroll
        for (int bj = 0; bj < 2; ++bj)
#pragma unroll
            for (int n = 0; n < 2; ++n) bv[bj][n] = bias ? *(const f32x4*)(bias + bcol0 + bj * HALF + 4 * n) : (f32x4){0.f, 0.f, 0.f, 0.f};
#pragma unroll
        for (int ai = 0; ai < 2; ++ai)
#pragma unroll
            for (int m = 0; m < 4; ++m) { bf16_t* rowp = base + (size_t)(row0 + ai * HALF + m * 16) * ldc + col0;
#pragma unroll
                for (int bj = 0; bj < 2; ++bj) { f32x4 v0 = acc[ai][bj][m][0] + bv[bj][0], v1 = acc[ai][bj][m][1] + bv[bj][1];
                    if (ACT == 1) { f32x2 a = gelu_pk((f32x2){v0[0], v0[1]}), b = gelu_pk((f32x2){v0[2], v0[3]}), c = gelu_pk((f32x2){v1[0], v1[1]}), d = gelu_pk((f32x2){v1[2], v1[3]});
                        v0 = (f32x4){a.x, a.y, b.x, b.y}; v1 = (f32x4){c.x, c.y, d.x, d.y}; }
                    v0 = v0 * sc; v1 = v1 * sc; u32x4 w; w.x = cvt_pk_bf16(v0[0], v0[1]); w.y = cvt_pk_bf16(v0[2], v0[3]); w.z = cvt_pk_bf16(v1[0], v1[1]); w.w = cvt_pk_bf16(v1[2], v1[3]);
                    *(u32x4*)(rowp + bj * HALF) = w; } }
    }
};
__device__ __forceinline__ unsigned cvtpk2(float lo, float hi) { typedef float f2 __attribute__((ext_vector_type(2))); typedef __bf16 b2 __attribute__((ext_vector_type(2))); f2 v = {lo, hi}; b2 b = __builtin_convertvector(v, b2); return __builtin_bit_cast(unsigned, b); }
template <int CTRL> __device__ __forceinline__ float dppz(float v) { return __builtin_bit_cast(float, __builtin_amdgcn_update_dpp(0, __builtin_bit_cast(int, v), CTRL, 0xf, 0xf, true)); }
template <int CTRL> __device__ __forceinline__ f32x4 dppz4(f32x4 v) { f32x4 r; r[0] = dppz<CTRL>(v[0]); r[1] = dppz<CTRL>(v[1]); r[2] = dppz<CTRL>(v[2]); r[3] = dppz<CTRL>(v[3]); return r; }
#ifdef V_NOSILU
__device__ __forceinline__ float silu_f(float x) { return x; }
#else
__device__ __forceinline__ float silu_f(float x) { return x * __builtin_amdgcn_rcpf(1.0f + __builtin_amdgcn_exp2f(-1.4426950408889634f * x)); }
#endif

struct EpiRes {
    static constexpr bool PERM = true, AFTER_DRAIN = false;
    const float* xin; const float* ctxin; bf16_t* X; const float* gate; int from_inputs;
    __device__ __forceinline__ void operator()(const f32x4 (&acc)[2][2][4][2], const Unit& u, int wr, int wc, int fr, int fq) const {
        const int b = u.pm / 9, j = u.pm - 9 * b, midx = (j == 8) ? 32 : b;
        bf16_t* xt = X + (size_t)u.pm * 256 * 1024;
        const int col0 = u.pn * BM + wc * 32 + 8 * fq;
        f32x4 gv[2][2];
#pragma unroll
        for (int bj = 0; bj < 2; ++bj)
#pragma unroll
            for (int n = 0; n < 2; ++n) gv[bj][n] = *(const f32x4*)(gate + (size_t)midx * 6144 + col0 + bj * HALF + n * 4);
        if (from_inputs) {
            const float* basef = (j < 8 ? xin + (size_t)(b * 2048 + 256 * j) * 1024 : ctxin + (size_t)b * 256 * 1024);
#pragma unroll
            for (int ai = 0; ai < 2; ++ai) {
                f32x4 fb[4][2][2];
#pragma unroll
                for (int m = 0; m < 4; ++m)
#pragma unroll
                    for (int bj = 0; bj < 2; ++bj) { const float* p = basef + (unsigned)((ai * HALF + wr * 64 + m * 16 + fr) * 1024 + col0) + bj * HALF; fb[m][bj][0] = *(const f32x4*)p; fb[m][bj][1] = *(const f32x4*)(p + 4); }
                asm volatile("" ::: "memory");
#pragma unroll
                for (int m = 0; m < 4; ++m) { const unsigned off = (unsigned)((ai * HALF + wr * 64 + m * 16 + fr) * 1024 + col0);
#pragma unroll
                    for (int bj = 0; bj < 2; ++bj) {
                        const f32x4 o0 = fb[m][bj][0] + gv[bj][0] * acc[ai][bj][m][0], o1 = fb[m][bj][1] + gv[bj][1] * acc[ai][bj][m][1];
                        u32x4 w; w.x = cvtpk2(o0[0], o0[1]); w.y = cvtpk2(o0[2], o0[3]); w.z = cvtpk2(o1[0], o1[1]); w.w = cvtpk2(o1[2], o1[3]);
                        *(u32x4*)(xt + off + bj * HALF) = w; } }
                asm volatile("" ::: "memory");
            }
        } else {
            u32x4 rb[2][4][2];
#pragma unroll
            for (int ai = 0; ai < 2; ++ai)
#pragma unroll
                for (int m = 0; m < 4; ++m)
#pragma unroll
                    for (int bj = 0; bj < 2; ++bj) rb[ai][m][bj] = *(const u32x4*)(xt + (unsigned)((ai * HALF + wr * 64 + m * 16 + fr) * 1024 + col0) + bj * HALF);
            asm volatile("" ::: "memory");
#pragma unroll
            for (int ai = 0; ai < 2; ++ai)
#pragma unroll
                for (int m = 0; m < 4; ++m) { const unsigned off = (unsigned)((ai * HALF + wr * 64 + m * 16 + fr) * 1024 + col0);
#pragma unroll
                    for (int bj = 0; bj < 2; ++bj) { const u32x4 r = rb[ai][m][bj];
                        const f32x4 b0 = (f32x4){__uint_as_float(r.x << 16), __uint_as_float(r.x & 0xffff0000u), __uint_as_float(r.y << 16), __uint_as_float(r.y & 0xffff0000u)};
                        const f32x4 b1 = (f32x4){__uint_as_float(r.z << 16), __uint_as_float(r.z & 0xffff0000u), __uint_as_float(r.w << 16), __uint_as_float(r.w & 0xffff0000u)};
                        const f32x4 o0 = b0 + gv[bj][0] * acc[ai][bj][m][0], o1 = b1 + gv[bj][1] * acc[ai][bj][m][1];
                        u32x4 w; w.x = cvtpk2(o0[0], o0[1]); w.y = cvtpk2(o0[2], o0[3]); w.z = cvtpk2(o1[0], o1[1]); w.w = cvtpk2(o1[2], o1[3]);
                        *(u32x4*)(xt + off + bj * HALF) = w; } }
        }
    }
};

struct EpiUpGate {
    static constexpr bool PERM = true, AFTER_DRAIN = false;
    bf16_t* A; float* SB; const float* cw; const float* cb; PG8_LAS float* cl  ;
    __device__ __forceinline__ void operator()(const f32x4 (&acc)[2][2][4][2], const Unit& u, int wr, int wc, int fr, int fq) const {
        const int jc = u.pn * 128 + wc * 32 + 8 * fq;
        PG8_LAS float* cwv = cl + (wr * 4 + wc) * 256;
        { const int v = fr + 16 * fq, hv = v >> 5, k = (v >> 3) & 3, c4 = v & 7;
          const float* src = (k < 3 ? cw + k * 5632 : cb) + hv * 2816 + u.pn * 128 + wc * 32 + 4 * c4;
          *(PG8_LAS f32x4*)(cwv + v * 4) = *(const f32x4*)src;
          asm volatile("s_waitcnt lgkmcnt(0)" ::: "memory"); }
#define CWL(hv_, k_, n_) (*(const PG8_LAS f32x4*)(cwv + ((hv_) * 4 + (k_)) * 32 + 8 * fq + 4 * (n_)))
#if 1
#pragma unroll
        for (int n = 0; n < 2; ++n) {
            const int j0 = jc + 4 * n;
            const f32x4 w0g = CWL(0, 0, n), w1g = CWL(0, 1, n), w2g = CWL(0, 2, n), bg = CWL(0, 3, n);
            const f32x4 w0v = CWL(1, 0, n), w1v = CWL(1, 1, n), w2v = CWL(1, 2, n), bv = CWL(1, 3, n);
#pragma unroll
            for (int ai = 0; ai < 2; ++ai) {
                float* sb = SB + ((size_t)(u.pm * 8 + 2 * (2 * ai + wr)) * 4) * 2816 + j0;
                { const f32x4 zg = acc[ai][0][0][n], zv = acc[ai][1][0][n];
                  const f32x4 cgv = w1g * zg + w2g * dppz4<0x101>(zg) + bg, cvv = w1v * zv + w2v * dppz4<0x101>(zv) + bv;
                  if (fr == 0) { *(f32x4*)(sb) = zg; *(f32x4*)(sb + 2816) = zv; *(f32x4*)(sb + 2 * 2816) = cgv; *(f32x4*)(sb + 3 * 2816) = cvv; } }
                { const f32x4 zg = acc[ai][0][3][n], zv = acc[ai][1][3][n];
                  const f32x4 cgv = w1g * zg + w0g * dppz4<0x111>(zg) + bg, cvv = w1v * zv + w0v * dppz4<0x111>(zv) + bv;
                  if (fr == 15) { float* sb1 = sb + 4 * 2816; *(f32x4*)(sb1) = zg; *(f32x4*)(sb1 + 2816) = zv; *(f32x4*)(sb1 + 2 * 2816) = cgv; *(f32x4*)(sb1 + 3 * 2816) = cvv; } }
                asm volatile("" ::: "memory"); __builtin_amdgcn_sched_barrier(0);
            }
        }
#endif
        unsigned pk[2][4][2];
#pragma unroll
        for (int n = 0; n < 2; ++n) {
            const int j0 = jc + 4 * n;
            const f32x4 w0g = CWL(0, 0, n), w1g = CWL(0, 1, n), w2g = CWL(0, 2, n), bg = CWL(0, 3, n);
            const f32x4 w0v = CWL(1, 0, n), w1v = CWL(1, 1, n), w2v = CWL(1, 2, n), bv = CWL(1, 3, n);
#pragma unroll
            for (int ai = 0; ai < 2; ++ai) {
#pragma unroll
                for (int m = 0; m < 4; ++m) {
                    const f32x4 zg = acc[ai][0][m][n], zv = acc[ai][1][m][n];
#ifdef V_NODPP
                    f32x4 pg = zg, pv = zv, ng = zg, nv = zv;
#else
                    f32x4 pg = dppz4<0x111>(zg), pv = dppz4<0x111>(zv), ng = dppz4<0x101>(zg), nv = dppz4<0x101>(zv);
                    if (m > 0) { pg += dppz4<0x10F>(acc[ai][0][m - 1][n]); pv += dppz4<0x10F>(acc[ai][1][m - 1][n]); }
                    if (m < 3) { ng += dppz4<0x11F>(acc[ai][0][m + 1][n]); nv += dppz4<0x11F>(acc[ai][1][m + 1][n]); }
#endif
                    const f32x4 cgv = w1g * zg + w0g * pg + w2g * ng + bg, cvv = w1v * zv + w0v * pv + w2v * nv + bv;
                    const int rho = 2 * ai + wr;
#if 0
                    if ((m == 0 && fr == 0) || (m == 3 && fr == 15)) {
                        float* sb = SB + ((size_t)(u.pm * 8 + 2 * rho + (m == 3 ? 1 : 0)) * 4) * 2816 + j0;
                        *(f32x4*)(sb) = zg; *(f32x4*)(sb + 2816) = zv; *(f32x4*)(sb + 2 * 2816) = cgv; *(f32x4*)(sb + 3 * 2816) = cvv;
                    }
#endif
                    const unsigned lo = cvtpk2(silu_f(cgv[0]) * cvv[0], silu_f(cgv[1]) * cvv[1]), hi = cvtpk2(silu_f(cgv[2]) * cvv[2], silu_f(cgv[3]) * cvv[3]);
                    if (n == 0) { pk[ai][m][0] = lo; pk[ai][m][1] = hi; }
                    else { u32x4 w; w.x = pk[ai][m][0]; w.y = pk[ai][m][1]; w.z = lo; w.w = hi;
                        *(u32x4*)(A + (size_t)(u.pm * BM + ai * HALF + wr * 64 + m * 16 + fr) * 2816 + jc) = w; }
                    if (m & 1) { asm volatile("" ::: "memory"); __builtin_amdgcn_sched_barrier(0); }
                }
            }
        }
    }
};
#undef CWL

struct TileOrder {
    int nM, nN, nwg, G, c, skip;
    __device__ void init(int nM_, int N, int G_, int c_, int skip_) { nM = nM_; nN = N / BM; nwg = nM * nN; G = G_; c = c_; skip = skip_; }
    __device__ bool next(int i, Unit& u) const {
        const long L = (long)i * G + c; if (L >= nwg) return false;
        int wgid = (int)L; { const int q = nwg / NXCD, r = nwg % NXCD, xcd = wgid % NXCD, off = wgid / NXCD; wgid = (xcd < r ? xcd * (q + 1) : r * (q + 1) + (xcd - r) * q) + off; }
        const int nig = WGM * nN, gid = wgid / nig, fm = gid * WGM, gsz = (nM - fm) < WGM ? (nM - fm) : WGM;
        int pm = fm + ((wgid % nig) % gsz); u.pn = (wgid % nig) / gsz;
        if (skip) pm = (pm >> 3) * 9 + (pm & 7);
        u.pm = pm; return true;
    }
    __device__ __forceinline__ void a_ready(const Unit&) const {}
    __device__ __forceinline__ void done(const Unit&) const {}
};
template <class Epi, class Sched, bool ALIGN_EPI = false, bool SP2 = false>
__device__ __forceinline__ void gemm_phase(PG8_LAS unsigned char* lds, const Gemm g, const Sched& S, const Epi& E) {
    const int tid = opaque_tid(), wid = __builtin_amdgcn_readfirstlane(tid >> 6), lane = tid & 63, wr = wid >> 2, wc = wid & 3, fr = lane & 15, fq = lane >> 4;
    const int K = g.K, nt = K / BK;
    unsigned voffA[2], voffB[2];
#pragma unroll
    for (int i = 0; i < 2; ++i) { int R, C; stage_rc(tid * 16 + i * 8192, R, C); const int Rb = Epi::PERM ? ((R & ~31) + perm32(R & 31)) : R;
        voffA[i] = (unsigned)(R * K + C) * 2u; voffB[i] = (unsigned)(Rb * K + C) * 2u; }
    const size_t kstep = (size_t)(BK * 2);
    const size_t hstep = (size_t)HALF * K * 2;
    const size_t tstep = 2 * hstep;
    const unsigned ldsw = (unsigned)wid * 1024u;
    const int aoff = lds_byte(wr * 64 + fr, fq * 8), boff = lds_byte(wc * 32 + fr, fq * 8);
#define PG8_SA(b, h) (((b) * 2 + (h)) * HTB)
#define PG8_SB(b, h) ((4 + (b) * 2 + (h)) * HTB)
#define PG8_STAGE(bufoff, gbase, voff) do { _Pragma("unroll") for (int _i = 0; _i < 2; ++_i) \
        __builtin_amdgcn_global_load_lds((const unsigned*)((const char*)(gbase) + (voff)[_i]), (PG8_LAS unsigned*)(lds + (bufoff) + ldsw + _i * 8192), 16, 0, 0); } while (0)
#define PG8_LDA(dst, b, h) do { _Pragma("unroll") for (int m = 0; m < 4; ++m) _Pragma("unroll") for (int k = 0; k < 2; ++k) dst[m][k] = *(const PG8_LAS bf16x8*)(lds + PG8_SA(b, h) + aoff + m * 2048 + k * 1024); } while (0)
#define PG8_LDB(dst, b, h) do { _Pragma("unroll") for (int n = 0; n < 2; ++n) _Pragma("unroll") for (int k = 0; k < 2; ++k) dst[n][k] = *(const PG8_LAS bf16x8*)(lds + PG8_SB(b, h) + boff + n * 2048 + k * 1024); } while (0)
#define PG8_MMA(ai, bj, At, Bt) do { __builtin_amdgcn_s_setprio(1); _Pragma("unroll") for (int m = 0; m < 4; ++m) _Pragma("unroll") for (int n = 0; n < 2; ++n) _Pragma("unroll") for (int k = 0; k < 2; ++k) \
        acc[ai][bj][m][n] = __builtin_amdgcn_mfma_f32_16x16x32_bf16(Bt[n][k], At[m][k], acc[ai][bj][m][n], 0, 0, 0); __builtin_amdgcn_s_setprio(0); } while (0)
#define PG8_WAIT_V(n) asm volatile("s_waitcnt vmcnt(" #n ")" ::: "memory")
#define PG8_WAIT_L(n) asm volatile("s_waitcnt lgkmcnt(" #n ")" ::: "memory")
#define PG8_BAR __builtin_amdgcn_s_barrier()
#define PG8_SCHED __builtin_amdgcn_sched_barrier(0)
    Unit cur, nxt; int ui = 0;
    if (!S.next(0, cur)) return;
    f32x4 acc[2][2][4][2];
#pragma unroll
    for (int a = 0; a < 2; ++a)
#pragma unroll
        for (int b = 0; b < 2; ++b)
#pragma unroll
            for (int m = 0; m < 4; ++m)
#pragma unroll
                for (int n = 0; n < 2; ++n) acc[a][b][m][n] = (f32x4){0.f, 0.f, 0.f, 0.f};
    bf16x8 At[4][2], B0[2][2], B1[2][2];
    const char* cA = (const char*)g.A + (size_t)cur.pm * tstep; const char* cB = (const char*)g.Bt + (size_t)cur.pn * tstep;
    S.a_ready(cur);
    if constexpr (SP2) {
        PG8_STAGE(PG8_SB(0, 0), cB, voffB); PG8_STAGE(PG8_SB(0, 1), cB + hstep, voffB); PG8_STAGE(PG8_SA(0, 0), cA, voffA); PG8_STAGE(PG8_SA(0, 1), cA + hstep, voffA);
        if (wr == 1) PG8_BAR;
        PG8_WAIT_V(2); PG8_BAR;
        PG8_STAGE(PG8_SB(1, 0), cB + kstep, voffB); PG8_STAGE(PG8_SA(1, 0), cA + kstep, voffA); PG8_STAGE(PG8_SB(1, 1), cB + hstep + kstep, voffB);
        PG8_WAIT_V(6); PG8_BAR;
    } else {
        PG8_STAGE(PG8_SB(0, 0), cB, voffB); PG8_STAGE(PG8_SA(0, 0), cA, voffA); PG8_STAGE(PG8_SB(0, 1), cB + hstep, voffB); PG8_STAGE(PG8_SA(0, 1), cA + hstep, voffA);
        if (wr == 1) PG8_BAR;
        PG8_WAIT_V(4); PG8_BAR;
        PG8_STAGE(PG8_SB(1, 0), cB + kstep, voffB); PG8_STAGE(PG8_SA(1, 0), cA + kstep, voffA); PG8_STAGE(PG8_SB(1, 1), cB + hstep + kstep, voffB);
        PG8_WAIT_V(6); PG8_BAR;
    }
    for (;;) {
        const bool has_next = S.next(ui + 1, nxt);
        const char* nA = has_next ? (const char*)g.A + (size_t)nxt.pm * tstep : cA; const char* nB = has_next ? (const char*)g.Bt + (size_t)nxt.pn * tstep : cB;
        for (int t = 0; t < nt; t += 2) {
            const bool last = (t == nt - 2);
            const char* a1 = cA + (size_t)(t + 1) * kstep;
            const char* a2 = last ? nA : cA + (size_t)(t + 2) * kstep; const char* b2 = last ? nB : cB + (size_t)(t + 2) * kstep;
            const char* a3 = a2 + kstep; const char* b3 = b2 + kstep;
            if (last && has_next) S.a_ready(nxt);
            if constexpr (SP2) {
            PG8_LDB(B0, 0, 0); PG8_LDB(B1, 0, 1); PG8_SCHED; PG8_LDA(At, 0, 0); PG8_STAGE(PG8_SA(1, 1), a1 + hstep, voffA);
            PG8_WAIT_V(8); PG8_WAIT_L(0); PG8_BAR; PG8_MMA(0, 0, At, B0); PG8_MMA(0, 1, At, B1); PG8_BAR; PG8_SCHED;
            PG8_LDA(At, 0, 1); PG8_STAGE(PG8_SB(0, 0), b2, voffB); PG8_STAGE(PG8_SB(0, 1), b2 + hstep, voffB); PG8_STAGE(PG8_SA(0, 0), a2, voffA);
            PG8_WAIT_V(8); PG8_WAIT_L(0); PG8_BAR; PG8_MMA(1, 0, At, B0); PG8_MMA(1, 1, At, B1); PG8_BAR; PG8_SCHED;
            PG8_LDB(B0, 1, 0); PG8_LDB(B1, 1, 1); PG8_SCHED; PG8_LDA(At, 1, 0); PG8_STAGE(PG8_SA(0, 1), a2 + hstep, voffA);
            PG8_WAIT_V(8); PG8_WAIT_L(0); PG8_BAR; PG8_MMA(0, 0, At, B0); PG8_MMA(0, 1, At, B1); PG8_BAR; PG8_SCHED;
            PG8_LDA(At, 1, 1); PG8_STAGE(PG8_SB(1, 0), b3, voffB); PG8_STAGE(PG8_SB(1, 1), b3 + hstep, voffB); PG8_STAGE(PG8_SA(1, 0), a3, voffA);
            PG8_WAIT_V(8); PG8_WAIT_L(0); PG8_BAR; PG8_MMA(1, 0, At, B0); PG8_MMA(1, 1, At, B1); PG8_BAR; PG8_SCHED;
            } else {
            PG8_LDB(B0, 0, 0); PG8_SCHED; PG8_LDA(At, 0, 0); PG8_STAGE(PG8_SA(1, 1), a1 + hstep, voffA);
            PG8_WAIT_L(8); PG8_BAR; PG8_WAIT_L(0); PG8_MMA(0, 0, At, B0); PG8_BAR; PG8_SCHED;
            PG8_LDB(B1, 0, 1); PG8_STAGE(PG8_SB(0, 0), b2, voffB);
            PG8_BAR; PG8_WAIT_L(0); PG8_MMA(0, 1, At, B1); PG8_BAR;
            PG8_LDA(At, 0, 1); PG8_STAGE(PG8_SA(0, 0), a2, voffA);
            PG8_BAR; PG8_WAIT_L(0); PG8_MMA(1, 0, At, B0); PG8_BAR; PG8_SCHED;
            PG8_STAGE(PG8_SB(0, 1), b2 + hstep, voffB);
            PG8_WAIT_V(6); PG8_BAR; PG8_MMA(1, 1, At, B1); PG8_BAR;
            PG8_LDB(B0, 1, 0); PG8_SCHED; PG8_LDA(At, 1, 0); PG8_STAGE(PG8_SA(0, 1), a2 + hstep, voffA);
            PG8_WAIT_L(8); PG8_BAR; PG8_WAIT_L(0); PG8_MMA(0, 0, At, B0); PG8_BAR; PG8_SCHED;
            PG8_LDB(B1, 1, 1); PG8_STAGE(PG8_SB(1, 0), b3, voffB);
            PG8_BAR; PG8_WAIT_L(0); PG8_MMA(0, 1, At, B1); PG8_BAR;
            PG8_LDA(At, 1, 1); PG8_STAGE(PG8_SA(1, 0), a3, voffA);
            PG8_BAR; PG8_WAIT_L(0); PG8_MMA(1, 0, At, B0); PG8_BAR; PG8_SCHED;
            PG8_STAGE(PG8_SB(1, 1), b3 + hstep, voffB);
            PG8_WAIT_V(6); PG8_BAR; PG8_MMA(1, 1, At, B1); PG8_BAR;
            }
        }
        if constexpr (ALIGN_EPI) { if (wr == 0) PG8_BAR; }
        if constexpr (!Epi::AFTER_DRAIN) { E(acc, cur, wr, wc, fr, fq); S.done(cur); }
        if (!has_next) break;
#pragma unroll
        for (int a = 0; a < 2; ++a)
#pragma unroll
            for (int b = 0; b < 2; ++b)
#pragma unroll
                for (int m = 0; m < 4; ++m)
#pragma unroll
                    for (int n = 0; n < 2; ++n) acc[a][b][m][n] = (f32x4){0.f, 0.f, 0.f, 0.f};
        cur = nxt; cA = nA; cB = nB; ++ui;
        if constexpr (ALIGN_EPI) { if (wr == 1) PG8_BAR; }
    }
    PG8_WAIT_V(0);
    if constexpr (!ALIGN_EPI) { if (wr == 0) PG8_BAR; }
    PG8_BAR;
    if constexpr (Epi::AFTER_DRAIN) { E.fused(acc, cur, wr, wc, fr, fq, lds, wid, lane); S.done(cur); }
#undef PG8_SA
#undef PG8_SB
#undef PG8_STAGE
#undef PG8_LDA
#undef PG8_LDB
#undef PG8_MMA
#undef PG8_WAIT_V
#undef PG8_WAIT_L
#undef PG8_BAR
#undef PG8_SCHED
}
}

#include <hip/hip_bf16.h>
#include <cmath>
namespace attn_body {
using bf16=__hip_bfloat16;
using bf16x8=__attribute__((ext_vector_type(8)))short;
using s16x4=__attribute__((ext_vector_type(4)))short;
using f32x16=__attribute__((ext_vector_type(16)))float;
using u32x4=__attribute__((ext_vector_type(4)))unsigned;
constexpr int D=64,PK=1536,PO=1024;
constexpr int NW=8,QBLK=32,QB=QBLK*NW,KVBLK=64;
constexpr int ATTN_UNIT_ROWS=QB;
__device__ __forceinline__ int crow(int r,int hi){return (r&3)+8*(r>>2)+4*hi;}
#define SBAR() __builtin_amdgcn_sched_barrier(0)
__device__ __forceinline__ void cmask(f32x16&p0,f32x16&p1,int jb,int qrel,int hi){
  const float NEG=-INFINITY; int kb=64*jb+4*hi;
  #pragma unroll
  for(int r=0;r<16;++r){int kv=kb+(r&3)+8*(r>>2); if(kv>qrel)p0[r]=NEG; if(kv+32>qrel)p1[r]=NEG;}
}

constexpr int NSLOT=3, SLOTB=8192;
constexpr int LDS_K=0, LDS_V=NSLOT*SLOTB, LDS_WS=2*NSLOT*SLOTB, LDS_OST=LDS_WS+NW*64*4, LDS_BYTES=LDS_OST+NW*4096;
constexpr float C2=0.125f*1.4426950408889634f;
__device__ __forceinline__ void glds16(const void*gsrc,unsigned lds_dst){unsigned keep;
  asm volatile("s_mov_b32 %0, m0\n\ts_mov_b32 m0, %2\n\ts_nop 0\n\tglobal_load_lds_dwordx4 %1, off\n\ts_mov_b32 m0, %0":"=&s"(keep):"v"(gsrc),"s"(lds_dst):"memory");}
__device__ __forceinline__ float max3f(float a,float b,float c){float r;asm("v_max3_f32 %0, %1, %2, %3":"=v"(r):"v"(a),"v"(b),"v"(c));return r;}
__device__ __forceinline__ float max2f(float a,float b){float r;asm("v_max_f32_e32 %0, %1, %2":"=v"(r):"v"(a),"v"(b));return r;}
__device__ __forceinline__ float fadd_s(float a,float b){float r;asm("v_add_f32_e32 %0, %1, %2":"=v"(r):"v"(a),"v"(b));return r;}
__device__ __forceinline__ float fsub_s(float a,float b){float r;asm("v_sub_f32_e32 %0, %1, %2":"=v"(r):"v"(a),"v"(b));return r;}
typedef float f32x2_t __attribute__((ext_vector_type(2))); typedef __bf16 bf16x2_t __attribute__((ext_vector_type(2)));
__device__ __forceinline__ unsigned cvtpk_s(float lo,float hi){f32x2_t v={lo,hi};bf16x2_t b=__builtin_convertvector(v,bf16x2_t);return __builtin_bit_cast(unsigned,b);}
#define WAIT_BAR(N) asm volatile("s_waitcnt vmcnt(" #N ") lgkmcnt(0)\n\ts_barrier":::"memory")

__device__ __forceinline__ void qkt(f32x16&p0,f32x16&p1,const char*Kslot,const bf16x8*qr,const f32x16&negm,int r32,int hi){
  const char*kb=Kslot+hi*1024+r32*16;
  #pragma unroll
  for(int d0=0;d0<4;++d0){
    const bf16x8 b0=*reinterpret_cast<const bf16x8*>(kb+d0*2048);
    const bf16x8 b1=*reinterpret_cast<const bf16x8*>(kb+d0*2048+512);
    if(d0==0){p0=__builtin_amdgcn_mfma_f32_32x32x16_bf16(b0,qr[0],negm,0,0,0);p1=__builtin_amdgcn_mfma_f32_32x32x16_bf16(b1,qr[0],negm,0,0,0);}
    else{p0=__builtin_amdgcn_mfma_f32_32x32x16_bf16(b0,qr[d0],p0,0,0,0);p1=__builtin_amdgcn_mfma_f32_32x32x16_bf16(b1,qr[d0],p1,0,0,0);}}
}
typedef __attribute__((address_space(3))) const char* lds_cptr;
typedef short v4i16_t __attribute__((ext_vector_type(4)));
__device__ __forceinline__ void kload8(bf16x8*kf,lds_cptr kp){
  kf[0]=*(const __attribute__((address_space(3))) bf16x8*)(kp);      kf[1]=*(const __attribute__((address_space(3))) bf16x8*)(kp+512);
  kf[2]=*(const __attribute__((address_space(3))) bf16x8*)(kp+2048); kf[3]=*(const __attribute__((address_space(3))) bf16x8*)(kp+2560);
  kf[4]=*(const __attribute__((address_space(3))) bf16x8*)(kp+4096); kf[5]=*(const __attribute__((address_space(3))) bf16x8*)(kp+4608);
  kf[6]=*(const __attribute__((address_space(3))) bf16x8*)(kp+6144); kf[7]=*(const __attribute__((address_space(3))) bf16x8*)(kp+6656);
}
__device__ __forceinline__ void kload2(bf16x8*kf,lds_cptr kp,int j){ kf[2*j]=*(const __attribute__((address_space(3))) bf16x8*)(kp+j*2048); kf[2*j+1]=*(const __attribute__((address_space(3))) bf16x8*)(kp+j*2048+512); }
__device__ __forceinline__ s16x4 vtr(lds_cptr p){ return __builtin_bit_cast(s16x4,__builtin_amdgcn_ds_read_tr16_b64_v4i16((__attribute__((address_space(3))) v4i16_t*)p)); }
__device__ __forceinline__ float rowmax(const f32x16&p0,const f32x16&p1){
  float a=max3f(p0[0],p0[1],p1[0]),b=max3f(p0[2],p0[3],p1[1]);a=max3f(a,p1[2],p1[3]);
  #pragma unroll
  for(int r=4;r<16;r+=4){a=max3f(a,p0[r],p0[r+1]);b=max3f(b,p0[r+2],p0[r+3]);a=max3f(a,p1[r],p1[r+1]);b=max3f(b,p1[r+2],p1[r+3]);}
  const float m=max2f(a,b);
  auto rr=__builtin_amdgcn_permlane32_swap(__float_as_uint(m),__float_as_uint(m),false,false);
  return max2f(__uint_as_float(rr[0]),__uint_as_float(rr[1]));
}
__device__ __forceinline__ void pv(f32x16*o,int vb,bf16x8 pa0,bf16x8 pa1,bf16x8 pa2,bf16x8 pa3){
  #pragma unroll
  for(int d0=0;d0<2;++d0){s16x4 lo[4],hi[4];
    #pragma unroll
    for(int ks=0;ks<4;++ks){
      asm volatile("ds_read_b64_tr_b16 %0,%1 offset:%c2":"=&v"(lo[ks]):"v"(vb),"i"(d0*4096+ks*1024):"memory");
      asm volatile("ds_read_b64_tr_b16 %0,%1 offset:%c2":"=&v"(hi[ks]):"v"(vb),"i"(d0*4096+ks*1024+512):"memory");}
    asm volatile("s_waitcnt lgkmcnt(0)":::"memory");SBAR();
    #define PK(k) (bf16x8){lo[k][0],lo[k][1],lo[k][2],lo[k][3],hi[k][0],hi[k][1],hi[k][2],hi[k][3]}
    o[d0]=__builtin_amdgcn_mfma_f32_32x32x16_bf16(pa0,PK(0),o[d0],0,0,0);
    o[d0]=__builtin_amdgcn_mfma_f32_32x32x16_bf16(pa1,PK(1),o[d0],0,0,0);
    o[d0]=__builtin_amdgcn_mfma_f32_32x32x16_bf16(pa2,PK(2),o[d0],0,0,0);
    o[d0]=__builtin_amdgcn_mfma_f32_32x32x16_bf16(pa3,PK(3),o[d0],0,0,0);
    #undef PK
  }
}

#ifndef ATTN_STORE16
#define ATTN_STORE16(p,v) (*(u32x4*)(p)=(v))
#endif
template<int THRL> __device__ __forceinline__ void attn_unit(const bf16*Qu,const bf16*__restrict__ Kh,const bf16*__restrict__ Vh,bf16*Ou,const int NT,char*shm,const float*qgain,const int t0){
  const int tid=pg8::opaque_tid(),lane=tid&63,r32=lane&31,hi=lane>>5; const int wid=__builtin_amdgcn_readfirstlane(tid>>6);
  const bf16*Qw=Qu+(long)(wid*QBLK)*PK;
  const unsigned lds0=(unsigned)(uintptr_t)shm;
  float*wsf=(float*)(shm+LDS_WS)+wid*64;
  const bf16*ksrc=Kh+(long)lane*PK+wid*8;
  const bf16*vsrc=Vh+(long)(16*(wid&3)+(lane>>2))*PK+(wid>>2)*32+(lane&3)*8;
  const unsigned kdst=lds0+LDS_K+wid*1024, vdst=lds0+LDS_V+wid*1024;
  #define DMA_K(t,slot) glds16(ksrc+(long)(t)*KVBLK*PK,(unsigned)__builtin_amdgcn_readfirstlane(kdst+(slot)))
  #define DMA_V(t,slot) glds16(vsrc+(long)(t)*KVBLK*PK,(unsigned)__builtin_amdgcn_readfirstlane(vdst+(slot)))
  const int vb0=(int)(lds0+LDS_V)+((lane>>4)&1)*32+(lane&3)*8+(4*hi+((lane&15)>>2))*64;
  const char*Kbase=shm+LDS_K; bf16x8 kf[8];
  const lds_cptr shm3=(lds_cptr)shm; const lds_cptr kp0=shm3+LDS_K+hi*1024+r32*16; const lds_cptr vp0=shm3+LDS_V+((lane>>4)&1)*32+(lane&3)*8+(4*hi+((lane&15)>>2))*64;
  DMA_K(0,0);DMA_V(0,0);DMA_K(1,SLOTB);
  bf16x8 qr[4];
  #pragma unroll
  for(int d0=0;d0<4;++d0)qr[d0]=*reinterpret_cast<const bf16x8*>(&Qw[(long)r32*PK+d0*16+hi*8]);
  {
    float qv[4][8];
    #pragma unroll
    for(int d0=0;d0<4;++d0){const u32x4 w=__builtin_bit_cast(u32x4,qr[d0]);
      qv[d0][0]=__uint_as_float(w.x<<16);qv[d0][1]=__uint_as_float(w.x&0xffff0000u);qv[d0][2]=__uint_as_float(w.y<<16);qv[d0][3]=__uint_as_float(w.y&0xffff0000u);
      qv[d0][4]=__uint_as_float(w.z<<16);qv[d0][5]=__uint_as_float(w.z&0xffff0000u);qv[d0][6]=__uint_as_float(w.w<<16);qv[d0][7]=__uint_as_float(w.w&0xffff0000u);}
    float ss=0.f;
    #pragma unroll
    for(int d0=0;d0<4;++d0){
      #pragma unroll
      for(int i=0;i<8;++i)ss+=qv[d0][i]*qv[d0][i];}
    {auto rr=__builtin_amdgcn_permlane32_swap(__float_as_uint(ss),__float_as_uint(ss),false,false);ss=__uint_as_float(rr[0])+__uint_as_float(rr[1]);}
    const float rstd=1.0f/sqrtf(ss*(1.0f/64.0f)+1e-6f);
    #pragma unroll
    for(int d0=0;d0<4;++d0){
      #pragma unroll
      for(int i=0;i<8;++i)qv[d0][i]=qv[d0][i]*rstd*qgain[d0*16+hi*8+i];}
    if(t0>=0){const int tq=t0+wid*QBLK+r32;const float rp=(float)(tq>>6),cp=(float)(tq&63);
      #pragma unroll
      for(int i=0;i<8;++i){const float inv=exp2f(-(float)(hi*8+i)*(13.287712379549449f/16.0f));
        {const float a=rp*inv,c=__cosf(a),s=__sinf(a),x1=qv[0][i],x2=qv[1][i];qv[0][i]=x1*c-x2*s;qv[1][i]=x2*c+x1*s;}
        {const float a=cp*inv,c=__cosf(a),s=__sinf(a),x1=qv[2][i],x2=qv[3][i];qv[2][i]=x1*c-x2*s;qv[3][i]=x2*c+x1*s;}}}
    #pragma unroll
    for(int d0=0;d0<4;++d0){u32x4 w;w.x=cvtpk_s(qv[d0][0]*C2,qv[d0][1]*C2);w.y=cvtpk_s(qv[d0][2]*C2,qv[d0][3]*C2);w.z=cvtpk_s(qv[d0][4]*C2,qv[d0][5]*C2);w.w=cvtpk_s(qv[d0][6]*C2,qv[d0][7]*C2);qr[d0]=__builtin_bit_cast(bf16x8,w);}
  }
  float mhat=0.f,l_reg=0.f;f32x16 o[2];o[0]=f32x16{};o[1]=f32x16{};f32x16 negm=f32x16{};asm volatile("":"+v"(negm));
  #define CMASK(P0,P1,t) do{}while(0)
  bool resc=false;
  #define START(P0,P1) do{ const float rm=rowmax(P0,P1); resc=false; \
    { const float dl=rm; mhat=fadd_s(mhat,dl); \
      _Pragma("unroll") for(int r=0;r<16;++r){P0[r]=fsub_s(P0[r],dl);P1[r]=fsub_s(P1[r],dl);} \
      _Pragma("unroll") for(int r=0;r<16;++r)negm[r]=-mhat; asm volatile("":"+v"(negm)); } \
    _Pragma("unroll") for(int r=0;r<16;++r)P0[r]=__builtin_amdgcn_exp2f(P0[r]); }while(0)
  #define RESC() do{ if(resc){ asm volatile("s_waitcnt lgkmcnt(0)":::"memory"); \
      _Pragma("unroll") for(int d_=0;d_<2;++d_) _Pragma("unroll") for(int r=0;r<16;++r)o[d_][r]*=wsf[crow(r,hi)]; } }while(0)
  f32x16 pA0,pA1,pB0,pB1;
  int sl_prev=0,sl_cur=0,sl_next=SLOTB;
  #define ROT() do{sl_prev=sl_cur;sl_cur=sl_next;sl_next=(sl_next==(NSLOT-1)*SLOTB)?0:sl_next+SLOTB;}while(0)
  DMA_K(2,2*SLOTB);
  WAIT_BAR(3);
  qkt(pA0,pA1,Kbase,qr,negm,r32,hi);asm volatile("s_nop 15\n\ts_nop 7":"+v"(pA0),"+v"(pA1));CMASK(pA0,pA1,0);
  START(pA0,pA1);
  _Pragma("unroll") for(int r=0;r<16;++r)pA1[r]=__builtin_amdgcn_exp2f(pA1[r]);
  WAIT_BAR(0);
  DMA_K(3,0);DMA_V(1,SLOTB);
  ROT();
  kload8(kf,kp0+sl_cur);
  WAIT_BAR(2);
  s16x4 vlo[8],vhi[8]; u32x4 pw0,pw1,pw2,pw3;
  #define PKW(P,B) cvtpk_s(P[B],P[B+1])
  #define PAF(k) __builtin_bit_cast(bf16x8,pw##k)
  #define VFR(i) (bf16x8){vlo[i][0],vlo[i][1],vlo[i][2],vlo[i][3],vhi[i][0],vhi[i][1],vhi[i][2],vhi[i][3]}
  #define PIN(x) asm volatile("":"+v"(x))
  #define MX3(a,b,c) __builtin_fmaxf(__builtin_fmaxf((a),(b)),(c))
  #define GAPA(MF,A0,A1,A2,A3,W0,W1,PW) do{ MF; sacc+=A0; sacc+=A1; sacc+=A2; sacc+=A3; PIN(sacc); W0; W1; PIN(PW); SBAR(); }while(0)
  #define EX(v) __builtin_amdgcn_exp2f(v)
  #define GAPB(MF,X,B) do{ MF; X[B]=EX(X[B]); X[B+1]=EX(X[B+1]); X[B+2]=EX(X[B+2]); X[B+3]=EX(X[B+3]); PIN(X); SBAR(); }while(0)
  #define VRD(i) do{ vlo[i]=vtr(vp_+(((i)>>2)*4096+((i)&3)*1024)); vhi[i]=vtr(vp_+(((i)>>2)*4096+((i)&3)*1024+512)); }while(0)
  #define KRD(G,j) do{ if(G){ kload2(kf,kp0+sl_next,j); SBAR(); } }while(0)
  #define STEP(C0,C1,P0,P1,t,GK,GV,GL) do{ SBAR(); \
    const lds_cptr vp_=vp0+sl_prev; \
    VRD(0); SBAR(); float sacc=(P0[0]+P0[1]); \
    GAPA(C0=__builtin_amdgcn_mfma_f32_32x32x16_bf16(kf[0],qr[0],negm,0,0,0), P0[2],P0[3],P0[4],P0[5],     pw0[0]=PKW(P0,0), pw0[1]=PKW(P0,2), pw0); \
    VRD(4); SBAR(); GAPA(C1=__builtin_amdgcn_mfma_f32_32x32x16_bf16(kf[1],qr[0],negm,0,0,0), P0[6],P0[7],P0[8],P0[9],     pw0[2]=PKW(P0,4), pw0[3]=PKW(P0,6), pw0); \
    VRD(1); SBAR(); GAPA(C0=__builtin_amdgcn_mfma_f32_32x32x16_bf16(kf[2],qr[1],C0,0,0,0),   P0[10],P0[11],P0[12],P0[13], pw1[0]=PKW(P0,8), pw1[1]=PKW(P0,10), pw1); \
    VRD(5); SBAR(); GAPA(C1=__builtin_amdgcn_mfma_f32_32x32x16_bf16(kf[3],qr[1],C1,0,0,0),   P0[14],P0[15],P1[0],P1[1],   pw1[2]=PKW(P0,12),pw1[3]=PKW(P0,14), pw1); \
    VRD(2); SBAR(); GAPA(C0=__builtin_amdgcn_mfma_f32_32x32x16_bf16(kf[4],qr[2],C0,0,0,0),   P1[2],P1[3],P1[4],P1[5],     pw2[0]=PKW(P1,0), pw2[1]=PKW(P1,2), pw2); \
    VRD(6); SBAR(); GAPA(C1=__builtin_amdgcn_mfma_f32_32x32x16_bf16(kf[5],qr[2],C1,0,0,0),   P1[6],P1[7],P1[8],P1[9],     pw2[2]=PKW(P1,4), pw2[3]=PKW(P1,6), pw2); \
    VRD(3); SBAR(); GAPA(C0=__builtin_amdgcn_mfma_f32_32x32x16_bf16(kf[6],qr[3],C0,0,0,0),   P1[10],P1[11],P1[12],P1[13], pw3[0]=PKW(P1,8), pw3[1]=PKW(P1,10), pw3); \
    VRD(7); SBAR(); GAPA(C1=__builtin_amdgcn_mfma_f32_32x32x16_bf16(kf[7],qr[3],C1,0,0,0),   P1[14],P1[15],0.f,0.f,       pw3[2]=PKW(P1,12),pw3[3]=PKW(P1,14), pw3); \
    l_reg+=sacc; \
    if(GK){DMA_K((t)+3,sl_cur);} if(GV){DMA_V((t)+1,sl_next);} \
    CMASK(C0,C1,t); \
    { float a=MX3(C0[0],C0[1],C1[0]),b=MX3(C0[2],C0[3],C1[1]); a=MX3(a,C1[2],C1[3]); \
      _Pragma("unroll") for(int r=4;r<16;r+=4){a=MX3(a,C0[r],C0[r+1]);b=MX3(b,C0[r+2],C0[r+3]);a=MX3(a,C1[r],C1[r+1]);b=MX3(b,C1[r+2],C1[r+3]);} \
      float rm=__builtin_fmaxf(a,b); { auto rr=__builtin_amdgcn_permlane32_swap(__float_as_uint(rm),__float_as_uint(rm),false,false); rm=__builtin_fmaxf(__uint_as_float(rr[0]),__uint_as_float(rr[1])); } \
      resc=false; \
      if(__builtin_expect(__any(rm>(float)THRL),0)){ const float dl=__builtin_fmaxf(rm,0.f); mhat+=dl; \
        _Pragma("unroll") for(int r=0;r<16;++r){C0[r]-=dl;C1[r]-=dl;} \
        _Pragma("unroll") for(int r=0;r<16;++r)negm[r]=-mhat; asm volatile("":"+v"(negm)); \
        const float f=__builtin_amdgcn_exp2f(-dl); l_reg*=f; if(hi==0)wsf[r32]=f; resc=true; } } \
    SBAR(); \
    GAPB(o[0]=__builtin_amdgcn_mfma_f32_32x32x16_bf16(PAF(0),VFR(0),o[0],0,0,0), C0,0); \
    GAPB(o[1]=__builtin_amdgcn_mfma_f32_32x32x16_bf16(PAF(0),VFR(4),o[1],0,0,0), C0,4); \
    KRD(GL,0); GAPB(o[0]=__builtin_amdgcn_mfma_f32_32x32x16_bf16(PAF(1),VFR(1),o[0],0,0,0), C0,8); \
    KRD(GL,1); GAPB(o[1]=__builtin_amdgcn_mfma_f32_32x32x16_bf16(PAF(1),VFR(5),o[1],0,0,0), C0,12); \
    KRD(GL,2); GAPB(o[0]=__builtin_amdgcn_mfma_f32_32x32x16_bf16(PAF(2),VFR(2),o[0],0,0,0), C1,0); \
    KRD(GL,3); GAPB(o[1]=__builtin_amdgcn_mfma_f32_32x32x16_bf16(PAF(2),VFR(6),o[1],0,0,0), C1,4); \
    GAPB(o[0]=__builtin_amdgcn_mfma_f32_32x32x16_bf16(PAF(3),VFR(3),o[0],0,0,0), C1,8); \
    GAPB(o[1]=__builtin_amdgcn_mfma_f32_32x32x16_bf16(PAF(3),VFR(7),o[1],0,0,0), C1,12); \
    }while(0)
  int t=1;
  for(;t+5<NT;t+=2){
    STEP(pB0,pB1,pA0,pA1,t,true,true,true);     WAIT_BAR(2); RESC(); ROT();
    STEP(pA0,pA1,pB0,pB1,t+1,true,true,true);   WAIT_BAR(2); RESC(); ROT();
  }
  #define ENDW(tt) do{ if((tt)+3<NT){WAIT_BAR(2);} else if((tt)+2<NT){WAIT_BAR(1);} else {WAIT_BAR(0);} }while(0)
  for(;t+1<NT;t+=2){
    STEP(pB0,pB1,pA0,pA1,t,(t+3<NT),(t+1<NT),(t+1<NT));       ENDW(t);   RESC(); ROT();
    STEP(pA0,pA1,pB0,pB1,t+1,(t+4<NT),(t+2<NT),(t+2<NT));     ENDW(t+1); RESC(); ROT();
  }
  STEP(pB0,pB1,pA0,pA1,NT-1,false,false,false); RESC();
  { float sacc=pB0[0]+pB0[1]; _Pragma("unroll") for(int r=2;r<16;++r)sacc+=pB0[r]; _Pragma("unroll") for(int r=0;r<16;++r)sacc+=pB1[r]; l_reg+=sacc;
    pw0=(u32x4){PKW(pB0,0),PKW(pB0,2),PKW(pB0,4),PKW(pB0,6)};pw1=(u32x4){PKW(pB0,8),PKW(pB0,10),PKW(pB0,12),PKW(pB0,14)};pw2=(u32x4){PKW(pB1,0),PKW(pB1,2),PKW(pB1,4),PKW(pB1,6)};pw3=(u32x4){PKW(pB1,8),PKW(pB1,10),PKW(pB1,12),PKW(pB1,14)};
    SBAR(); pv(o,vb0+sl_cur,PAF(0),PAF(1),PAF(2),PAF(3)); }
  #undef PKW
  #undef PAF
  #undef VFR
  #undef PIN
  #undef MX3
  #undef GAPA
  #undef GAPB
  #undef EX
  #undef VRD
  #undef KRD
  #undef STEP
  #undef ENDW
  {auto rr=__builtin_amdgcn_permlane32_swap(__float_as_uint(l_reg),__float_as_uint(l_reg),false,false);l_reg=__uint_as_float(rr[0])+__uint_as_float(rr[1]);}
  if(hi==0)wsf[32+r32]=l_reg;asm volatile("s_waitcnt lgkmcnt(0)":::"memory");
  float rli[16];
  #pragma unroll
  for(int r=0;r<16;++r)rli[r]=__builtin_amdgcn_rcpf(wsf[32+crow(r,hi)]);
  bf16*Ow=Ou+(long)(wid*QBLK)*PO;
  { bf16*stg=(bf16*)(shm+LDS_OST)+wid*2048;
    #pragma unroll
    for(int r=0;r<16;++r){const int orow=crow(r,hi);
      #pragma unroll
      for(int d0=0;d0<2;++d0)stg[orow*64+d0*32+r32]=__float2bfloat16(o[d0][r]*rli[r]);}
    asm volatile("s_waitcnt lgkmcnt(0)":::"memory");
    #pragma unroll
    for(int i=0;i<4;++i){const int row=i*8+(lane>>3),ch=lane&7; const u32x4 v=*(const u32x4*)(stg+row*64+ch*8); ATTN_STORE16(Ow+(long)row*PO+ch*8,v);} }
  asm volatile("s_waitcnt lgkmcnt(0)\n\ts_barrier":::"memory");
  #undef DMA_K
  #undef DMA_V
  #undef CMASK
  #undef START
  #undef RESC
  #undef ROT
}
constexpr int ATTN_LDS_BYTES=LDS_BYTES;
#undef SBAR
#undef WAIT_BAR
}
constexpr int NB = 32, SEQ = 2048, CTXL = 256, TPB = SEQ + CTXL, MTOK = NB * TPB, DM = 1024, INW = 1536, FF = 2816, FF2 = 5632, MODW = 6144, NLAYER = 2;
constexpr int NTILE = MTOK / 256;
constexpr float EPS = 1e-6f;
constexpr size_t MiB = 1u << 20;
constexpr size_t WS_BAR = 0;
constexpr size_t WS_MOD = 1 * MiB;
constexpr size_t WS_WSB = 3 * MiB;
constexpr size_t WS_WPT = 3 * MiB + 512 * 1024;
constexpr size_t WS_PRM = 3 * MiB + 768 * 1024;
constexpr int PRM_N1G = 0, PRM_N2G = 1024, PRM_QG = 2048, PRM_KG = 2112, PRM_BS = 2176, PRM_PSC = 2688, PRM_CW = 2944, PRM_CB = PRM_CW + 3 * 5632, PRM_L = PRM_CB + 5632;
constexpr size_t WS_WIN = 4 * MiB, WS_WOUT = 10 * MiB, WS_WUP = 14 * MiB, WS_WDN = 36 * MiB;
constexpr size_t WS_SB = 48 * MiB;
constexpr size_t WS_X = 148 * MiB;
constexpr size_t WS_H = 436 * MiB;
constexpr size_t WS_P = 580 * MiB;
constexpr size_t WS_MIX = 796 * MiB;
constexpr size_t WS_A = 580 * MiB;
constexpr size_t WS_END = 976 * MiB;
static_assert(WS_SB + (size_t)NTILE * 8 * 4 * 2816 * 4 <= WS_X && WS_X + (size_t)MTOK * 1024 * 4 <= WS_H && WS_H + (size_t)MTOK * 1024 * 2 <= WS_P && WS_P + (size_t)MTOK * 1536 * 2 <= WS_MIX && WS_MIX + (size_t)MTOK * 1024 * 2 <= WS_END && WS_A + (size_t)MTOK * 2816 * 2 <= WS_END, "d_ws map");
static_assert(WS_WDN + 2 * (size_t)1024 * 2816 * 2 <= WS_SB && WS_WUP + 2 * (size_t)5632 * 1024 * 2 <= WS_WDN && WS_WOUT + 2 * (size_t)1024 * 1024 * 2 <= WS_WUP && WS_WIN + 2 * (size_t)1536 * 1024 * 2 <= WS_WOUT, "weights map");
constexpr int LDS_BYTES = 147456;

#define LAS __attribute__((address_space(3)))
typedef unsigned short bf16;
typedef unsigned v4u __attribute__((ext_vector_type(4)));
typedef unsigned v2u __attribute__((ext_vector_type(2)));
typedef float f32x4 __attribute__((ext_vector_type(4)));
typedef short bf16x8 __attribute__((ext_vector_type(8)));
#define LDS_WAIT() asm volatile("s_waitcnt lgkmcnt(0)" ::: "memory")
__device__ __forceinline__ unsigned pk2(float lo, float hi) { return pg8::cvtpk2(lo, hi); }
__device__ __forceinline__ float bflo(unsigned u) { return __uint_as_float(u << 16); }
__device__ __forceinline__ float bfhi(unsigned u) { return __uint_as_float(u & 0xffff0000u); }
__device__ __forceinline__ float wave_sum(float v) {
#pragma unroll
    for (int o = 1; o < 64; o <<= 1) v += __shfl_xor(v, o);
    return v;
}

__device__ __forceinline__ void p0_transpose_item(const float* W, int K, int N, bf16* WT, bool upperm, LAS float* scr, int item, int lane) {
    const int nblk = N / 32, kb = item / nblk, nb = item % nblk, k0 = 64 * kb, n0 = 32 * nb;
#pragma unroll 8
    for (int i = 0; i < 32; ++i) { const int kk = 2 * i + (lane >> 5); scr[kk * 33 + (lane & 31)] = W[(size_t)(k0 + kk) * N + n0 + (lane & 31)]; }
    LDS_WAIT(); asm volatile("" ::: "memory");
    int r0 = n0;
    if (upperm) { const int j = (n0 < FF) ? n0 : n0 - FF; r0 = 256 * (j >> 7) + (j & 127) + ((n0 < FF) ? 0 : 128); }
    const int c = lane & 7;
#pragma unroll
    for (int j = 0; j < 4; ++j) { const int n = (lane >> 3) + 8 * j; const LAS float* s = scr + (8 * c) * 33 + n;
        v4u o; o.x = pk2(s[0 * 33], s[1 * 33]); o.y = pk2(s[2 * 33], s[3 * 33]); o.z = pk2(s[4 * 33], s[5 * 33]); o.w = pk2(s[6 * 33], s[7 * 33]);
        *(v4u*)(WT + (size_t)(r0 + n) * K + k0 + 8 * c) = o; }
    LDS_WAIT(); asm volatile("" ::: "memory");
}

#define XB_TMO      128
#define XB_XCNT(j)  (256  + 64 * (j))
#define XB_XSUB(j)  (1280 + 64 * (j))
#define XB_XGEN(j)  (2304 + 64 * (j))
#define XB_TOP      3328
#define XB_TOPGEN   3392
#define XCD_BAR_WORDS 3456
#define XB_SPIN_CAP (1u << 18)

__device__ __forceinline__ unsigned xb_ld(unsigned* p)              { return __hip_atomic_load(p, __ATOMIC_RELAXED, __HIP_MEMORY_SCOPE_AGENT); }
__device__ __forceinline__ unsigned xb_add(unsigned* p, unsigned v) { return __hip_atomic_fetch_add(p, v, __ATOMIC_RELAXED, __HIP_MEMORY_SCOPE_AGENT); }
__device__ __forceinline__ unsigned xb_xcc_id() { return (unsigned)__builtin_amdgcn_s_getreg((3 << 11) | 20) & 0xFu; }
#define XB_SPIN(cond, bar) do { unsigned _sp = 0; while (cond) { __builtin_amdgcn_s_sleep(1); \
    if ((++_sp & 255u) == 0u) { if (xb_ld(&(bar)[XB_TMO])) break; if (_sp > XB_SPIN_CAP) { atomicAdd(&(bar)[XB_TMO], 1u); break; } } } } while (0)

struct XcdBarrier {
    unsigned* bar; unsigned x;
    volatile LAS unsigned* st;
};

__device__ __forceinline__ XcdBarrier xcd_barrier_post(unsigned* bar, volatile LAS unsigned* st) {
    XcdBarrier b; b.bar = bar; b.x = xb_xcc_id(); b.st = st;
    if (threadIdx.x == 0) (void)xb_add(&bar[XB_XCNT(b.x)], 1u);
    return b;
}
__device__ __forceinline__ void xcd_barrier_complete(unsigned* bar, unsigned x, unsigned& nloc, unsigned& nx) {
    const unsigned G = gridDim.x * gridDim.y * gridDim.z;
    unsigned sum, cnt, mine, sp = 0u;
    for (;;) {
        sum = 0u; cnt = 0u; mine = 0u;
#pragma unroll
        for (unsigned j = 0; j < 16; ++j) { const unsigned c = xb_ld(&bar[XB_XCNT(j)]); sum += c; cnt += (c > 0u) ? 1u : 0u; mine = (j == x) ? c : mine; }
        if (sum == G) break;
        __builtin_amdgcn_s_sleep(1);
        if ((++sp & 255u) == 0u) { if (xb_ld(&bar[XB_TMO])) break; if (sp > XB_SPIN_CAP) { atomicAdd(&bar[XB_TMO], 1u); break; } }
    }
    nloc = mine > 0u ? mine : 1u; nx = cnt > 0u ? cnt : 1u;
}

__device__ __forceinline__ void xcd_barrier(const XcdBarrier& b) {
    asm volatile("s_waitcnt vmcnt(0)" ::: "memory");
    __syncthreads();
    if (threadIdx.x == 0) {
        unsigned* bar = b.bar;
        __builtin_amdgcn_s_waitcnt(0);
        unsigned nloc = b.st[0], nx = b.st[1];
        if (nloc == 0u) { xcd_barrier_complete(bar, b.x, nloc, nx); b.st[0] = nloc; b.st[1] = nx; }
        const unsigned old = xb_add(&bar[XB_XSUB(b.x)], 1u);
        const unsigned gen = old / nloc;
        if (old + 1u == (gen + 1u) * nloc) {
            __builtin_amdgcn_fence(__ATOMIC_RELEASE, "agent");
            asm volatile("s_waitcnt vmcnt(0)" ::: "memory");
            const unsigned og = xb_add(&bar[XB_TOP], 1u);
            const unsigned tg = og / nx;
            if (og + 1u == (tg + 1u) * nx) xb_add(&bar[XB_TOPGEN], 1u);
            else XB_SPIN(xb_ld(&bar[XB_TOPGEN]) == tg, bar);
            __builtin_amdgcn_fence(__ATOMIC_ACQUIRE, "agent");
            xb_add(&bar[XB_XGEN(b.x)], 1u);
            asm volatile("s_waitcnt vmcnt(0)" ::: "memory");
        } else {
            XB_SPIN(xb_ld(&bar[XB_XGEN(b.x)]) == gen, bar);
            __builtin_amdgcn_fence(__ATOMIC_ACQUIRE, "agent");
            asm volatile("s_waitcnt vmcnt(0)" ::: "memory");
        }
    }
    __syncthreads();
}

struct Args { const float* in[21]; float* out; unsigned char* ws; };

__device__ __forceinline__ void mod_phase(const Args& a, LAS unsigned char* lds, int tid) {
    LAS float* S = (LAS float*)lds;
    LAS float* OUT = (LAS float*)(lds + 33 * 1024 * 4);
    const float* c = a.in[1]; const float* cc = a.in[3]; const float* wmod = a.in[4]; const float* bmod = a.in[5];
    float* MOD = (float*)(a.ws + WS_MOD);
#pragma unroll 11
    for (int i = tid; i < 33 * 1024; i += 512) { const int m = i >> 10, k = i & 1023; const float v = (m < 32) ? c[m * 1024 + k] : cc[k]; S[i] = v / (1.0f + __expf(-v)); }
    __syncthreads();
    for (int u = blockIdx.x; u < 384; u += gridDim.x) {
        const int l = u / 192, col0 = (u % 192) * 32;
        for (int i = tid; i < 33 * 32; i += 512) OUT[i] = 0.f;
        __syncthreads();
        const int col = tid & 31, kc = tid >> 5;
        float acc[33];
#pragma unroll
        for (int m = 0; m < 33; ++m) acc[m] = 0.f;
        const float* W = wmod + (size_t)l * 1024 * MODW + col0 + col;
        for (int k4 = 0; k4 < 16; ++k4) {
            const int k = kc * 64 + k4 * 4;
            const float w0 = W[(size_t)(k + 0) * MODW], w1 = W[(size_t)(k + 1) * MODW], w2 = W[(size_t)(k + 2) * MODW], w3 = W[(size_t)(k + 3) * MODW];
#pragma unroll
            for (int m = 0; m < 33; ++m) { const f32x4 s = *(const LAS f32x4*)(S + m * 1024 + k); acc[m] += (s[0] * w0 + s[1] * w1) + (s[2] * w2 + s[3] * w3); }
        }
#pragma unroll
        for (int m = 0; m < 33; ++m) acc[m] += __shfl_xor(acc[m], 32);
        for (int w = 0; w < 8; ++w) {
            if ((tid >> 6) == w && (tid & 63) < 32) {
#pragma unroll
                for (int m = 0; m < 33; ++m) OUT[m * 32 + col] += acc[m];
            }
            __syncthreads();
        }
        for (int i = tid; i < 33 * 32; i += 512) { const int m = i >> 5, q = i & 31; MOD[(size_t)(l * 33 + m) * MODW + col0 + q] = OUT[i] + bmod[l * MODW + col0 + q]; }
        __syncthreads();
    }
}

__device__ __forceinline__ void norm_phase(const float* xin, const float* ctxin, const float* Xb, int from_inputs, const float* gvec, const float* mod, int sh_off, int sc_off,
                                           bf16* H, int skip_ctx, int gw, int NGW, int lane) {
    const int rpw = (MTOK + NGW - 1) / NGW; const int r0 = gw * rpw; int r1 = r0 + rpw; if (r1 > MTOK) r1 = MTOK;
    int cur = -1; f32x4 gs[4], shv[4];
#pragma unroll
    for (int j = 0; j < 4; ++j) { gs[j] = (f32x4){0.f, 0.f, 0.f, 0.f}; shv[j] = gs[j]; }
    for (int r = r0; r < r1; ++r) {
        const int b = r / TPB, t = r - b * TPB; const int midx = (t >= SEQ) ? 32 : b;
        if (skip_ctx && t >= SEQ) continue;
        if (midx != cur) { cur = midx;
#pragma unroll
            for (int j = 0; j < 4; ++j) { const int cidx = 4 * lane + 256 * j; const f32x4 g = *(const f32x4*)(gvec + cidx), sc = *(const f32x4*)(mod + (size_t)midx * MODW + sc_off + cidx);
                gs[j] = g * (sc + 1.0f); shv[j] = *(const f32x4*)(mod + (size_t)midx * MODW + sh_off + cidx); } }
        const float* xr = from_inputs ? (t < SEQ ? xin + ((size_t)b * SEQ + t) * DM : ctxin + ((size_t)b * CTXL + (t - SEQ)) * DM) : Xb + (size_t)r * DM;
        f32x4 v[4]; float ss = 0.f;
#pragma unroll
        for (int j = 0; j < 4; ++j) { v[j] = *(const f32x4*)(xr + 4 * lane + 256 * j); ss += (v[j][0] * v[j][0] + v[j][1] * v[j][1]) + (v[j][2] * v[j][2] + v[j][3] * v[j][3]); }
        const float rstd = 1.0f / sqrtf(wave_sum(ss) * (1.0f / DM) + EPS);
        bf16* hr = H + (size_t)r * DM;
#pragma unroll
        for (int j = 0; j < 4; ++j) { const f32x4 o = v[j] * rstd * gs[j] + shv[j]; v2u w; w.x = pk2(o[0], o[1]); w.y = pk2(o[2], o[3]); *(v2u*)(hr + 4 * lane + 256 * j) = w; }
    }
}
__device__ __forceinline__ void unpack8(v4u r, f32x4& a, f32x4& b) { a = (f32x4){bflo(r.x), bfhi(r.x), bflo(r.y), bfhi(r.y)}; b = (f32x4){bflo(r.z), bfhi(r.z), bflo(r.w), bfhi(r.w)}; }
__device__ __forceinline__ float sq8(const f32x4& a, const f32x4& b) { return ((a[0] * a[0] + a[1] * a[1]) + (a[2] * a[2] + a[3] * a[3])) + ((b[0] * b[0] + b[1] * b[1]) + (b[2] * b[2] + b[3] * b[3])); }
__device__ __forceinline__ void norm_phase_b(const bf16* Xb, const float* gvec, const float* mod, int sh_off, int sc_off, bf16* H, int skip_ctx, int gw, int NGW, int lane) {
    const int rpw = (((MTOK + NGW - 1) / NGW) + 1) & ~1; const int r0 = gw * rpw; int r1 = r0 + rpw; if (r1 > MTOK) r1 = MTOK;
    int cur = -1; f32x4 gs[2][2], shv[2][2];
#pragma unroll
    for (int j = 0; j < 2; ++j) { gs[j][0] = (f32x4){0.f, 0.f, 0.f, 0.f}; gs[j][1] = gs[j][0]; shv[j][0] = gs[j][0]; shv[j][1] = gs[j][0]; }
    for (int r = r0; r < r1; r += 2) {
        const int b = r / TPB, t = r - b * TPB; const int midx = (t >= SEQ) ? 32 : b;
        if (skip_ctx && t >= SEQ) continue;
        if (midx != cur) { cur = midx;
#pragma unroll
            for (int j = 0; j < 2; ++j)
#pragma unroll
                for (int q = 0; q < 2; ++q) { const int cidx = 8 * lane + 512 * j + 4 * q; const f32x4 g = *(const f32x4*)(gvec + cidx), sc = *(const f32x4*)(mod + (size_t)midx * MODW + sc_off + cidx);
                    gs[j][q] = g * (sc + 1.0f); shv[j][q] = *(const f32x4*)(mod + (size_t)midx * MODW + sh_off + cidx); } }
        const bf16* xr = Xb + (size_t)r * DM + 8 * lane;
        const v4u ra0 = *(const v4u*)(xr), ra1 = *(const v4u*)(xr + 512), rb0 = *(const v4u*)(xr + DM), rb1 = *(const v4u*)(xr + DM + 512);
        f32x4 a[2][2], c[2][2];
        unpack8(ra0, a[0][0], a[0][1]); unpack8(ra1, a[1][0], a[1][1]); unpack8(rb0, c[0][0], c[0][1]); unpack8(rb1, c[1][0], c[1][1]);
        float ss0 = sq8(a[0][0], a[0][1]) + sq8(a[1][0], a[1][1]), ss1 = sq8(c[0][0], c[0][1]) + sq8(c[1][0], c[1][1]);
#pragma unroll
        for (int o = 1; o < 64; o <<= 1) { ss0 += __shfl_xor(ss0, o); ss1 += __shfl_xor(ss1, o); }
        const float rstd0 = 1.0f / sqrtf(ss0 * (1.0f / DM) + EPS), rstd1 = 1.0f / sqrtf(ss1 * (1.0f / DM) + EPS);
        bf16* hr = H + (size_t)r * DM + 8 * lane;
#pragma unroll
        for (int j = 0; j < 2; ++j) {
            const f32x4 p0 = a[j][0] * rstd0 * gs[j][0] + shv[j][0], p1 = a[j][1] * rstd0 * gs[j][1] + shv[j][1];
            const f32x4 q0 = c[j][0] * rstd1 * gs[j][0] + shv[j][0], q1 = c[j][1] * rstd1 * gs[j][1] + shv[j][1];
            v4u w0; w0.x = pk2(p0[0], p0[1]); w0.y = pk2(p0[2], p0[3]); w0.z = pk2(p1[0], p1[1]); w0.w = pk2(p1[2], p1[3]); *(v4u*)(hr + 512 * j) = w0;
            v4u w1; w1.x = pk2(q0[0], q0[1]); w1.y = pk2(q0[2], q0[3]); w1.z = pk2(q1[0], q1[1]); w1.w = pk2(q1[2], q1[3]); *(v4u*)(hr + DM + 512 * j) = w1; }
    }
}
__device__ __forceinline__ void final_norm_phase(const bf16* Xb, const float* gvec, float* out, int gw, int NGW, int lane) {
    f32x4 g[2][2];
#pragma unroll
    for (int j = 0; j < 2; ++j)
#pragma unroll
        for (int q = 0; q < 2; ++q) g[j][q] = *(const f32x4*)(gvec + 8 * lane + 512 * j + 4 * q);
    for (int i = gw * 2; i < NB * SEQ; i += NGW * 2) {
        const int b = i / SEQ, t = i - b * SEQ; const bf16* xr = Xb + ((size_t)b * TPB + t) * DM + 8 * lane;
        const v4u ra0 = *(const v4u*)(xr), ra1 = *(const v4u*)(xr + 512), rb0 = *(const v4u*)(xr + DM), rb1 = *(const v4u*)(xr + DM + 512);
        f32x4 a[2][2], c[2][2];
        unpack8(ra0, a[0][0], a[0][1]); unpack8(ra1, a[1][0], a[1][1]); unpack8(rb0, c[0][0], c[0][1]); unpack8(rb1, c[1][0], c[1][1]);
        float ss0 = sq8(a[0][0], a[0][1]) + sq8(a[1][0], a[1][1]), ss1 = sq8(c[0][0], c[0][1]) + sq8(c[1][0], c[1][1]);
#pragma unroll
        for (int o = 1; o < 64; o <<= 1) { ss0 += __shfl_xor(ss0, o); ss1 += __shfl_xor(ss1, o); }
        const float rstd0 = 1.0f / sqrtf(ss0 * (1.0f / DM) + EPS), rstd1 = 1.0f / sqrtf(ss1 * (1.0f / DM) + EPS);
        float* orow = out + (size_t)i * DM + 8 * lane;
#pragma unroll
        for (int j = 0; j < 2; ++j)
#pragma unroll
            for (int q = 0; q < 2; ++q) { *(f32x4*)(orow + 512 * j + 4 * q) = a[j][q] * rstd0 * g[j][q]; *(f32x4*)(orow + DM + 512 * j + 4 * q) = c[j][q] * rstd1 * g[j][q]; }
    }
}

__device__ __forceinline__ v4u normrope8(v4u raw, const float* gain, int s, bool rope, float pos, const float (&invf)[8], float scale) {
    float v[8]; v[0] = bflo(raw.x); v[1] = bfhi(raw.x); v[2] = bflo(raw.y); v[3] = bfhi(raw.y); v[4] = bflo(raw.z); v[5] = bfhi(raw.z); v[6] = bflo(raw.w); v[7] = bfhi(raw.w);
    float ss = 0.f;
#pragma unroll
    for (int i = 0; i < 8; ++i) ss += v[i] * v[i];
    ss += __shfl_xor(ss, 1); ss += __shfl_xor(ss, 2); ss += __shfl_xor(ss, 4);
    const float rstd = 1.0f / sqrtf(ss * (1.0f / 64.0f) + EPS);
    const f32x4 g0 = *(const f32x4*)(gain + 8 * s), g1 = *(const f32x4*)(gain + 8 * s + 4);
    float y[8];
#pragma unroll
    for (int i = 0; i < 4; ++i) { y[i] = v[i] * rstd * g0[i]; y[4 + i] = v[4 + i] * rstd * g1[i]; }
    if (rope) {
#pragma unroll
        for (int i = 0; i < 8; ++i) { const float p = __shfl_xor(y[i], 2); const float ang = pos * invf[i]; const float cs = __cosf(ang), sn = __sinf(ang);
            y[i] = (s & 2) ? (y[i] * cs + p * sn) : (y[i] * cs - p * sn); }
    }
    v4u o; o.x = pk2(y[0] * scale, y[1] * scale); o.y = pk2(y[2] * scale, y[3] * scale); o.z = pk2(y[4] * scale, y[5] * scale); o.w = pk2(y[6] * scale, y[7] * scale);
    return o;
}
constexpr float QSCALE = 0.125f * 1.4426950408889634f;
__device__ __forceinline__ void normrope_phase(bf16* P, const float* kgain, int gw, int NGW, int lane) {
    const int s = lane & 7, q = lane >> 4, piece = lane & 15;
    float invf[8];
#pragma unroll
    for (int i = 0; i < 8; ++i) invf[i] = exp2f(-(float)(8 * (s & 1) + i) * (13.287712379549449f / 16.0f));
    const int rpw = (((MTOK + NGW - 1) / NGW) + 11) / 12 * 12; const int r0 = gw * rpw; int r1 = r0 + rpw; if (r1 > MTOK) r1 = MTOK;
    for (int r = r0; r < r1; r += 12) {
        v4u rk[3];
#pragma unroll
        for (int g = 0; g < 3; ++g) rk[g] = *(const v4u*)(P + (size_t)(r + 4 * g + q) * INW + 512 + 8 * piece);
#pragma unroll
        for (int g = 0; g < 3; ++g) {
            const int rr = r + 4 * g; const int b = rr / TPB, t = rr - b * TPB + q; const bool rope = t < SEQ;
            const float pos = (s < 4) ? (float)(t >> 6) : (float)(t & 63);
            *(v4u*)(P + (size_t)(rr + q) * INW + 512 + 8 * piece) = normrope8(rk[g], kgain, s, rope, pos, invf, 1.0f);
        }
    }
}

__device__ __forceinline__ void sgu_phase(const bf16* P, bf16* MIX, const bf16* Wsb  , const float* bs  , LAS unsigned char* lds, int wave, int gw, int NGW, int lane) {
    LAS unsigned short* vT = (LAS unsigned short*)(lds + wave * 17408);
    const int fr = lane & 15, fq = lane >> 4;
    for (int unit = gw; unit < (MTOK / 128) * 4; unit += NGW) {
        const int cidx = unit >> 2, g = unit & 3; const size_t row0 = (size_t)cidx * 128;
        v4u rawv[16];
#pragma unroll
        for (int it = 0; it < 16; ++it) { const int idx = it * 64 + lane, q = idx >> 3, pc = idx & 7; rawv[it] = *(const v4u*)(P + (row0 + q) * INW + 1024 + 64 * g + 8 * pc); }
#pragma unroll
        for (int it = 0; it < 16; ++it) { const int idx = it * 64 + lane, q = idx >> 3, pc = idx & 7;
            const v4u raw = rawv[it];
            LAS unsigned short* dst = vT + (8 * pc) * 136 + q;
            dst[0 * 136] = (unsigned short)(raw.x & 0xffffu); dst[1 * 136] = (unsigned short)(raw.x >> 16); dst[2 * 136] = (unsigned short)(raw.y & 0xffffu); dst[3 * 136] = (unsigned short)(raw.y >> 16);
            dst[4 * 136] = (unsigned short)(raw.z & 0xffffu); dst[5 * 136] = (unsigned short)(raw.z >> 16); dst[6 * 136] = (unsigned short)(raw.w & 0xffffu); dst[7 * 136] = (unsigned short)(raw.w >> 16); }
        LDS_WAIT(); asm volatile("" ::: "memory");
#pragma unroll 1
        for (int ph = 0; ph < 2; ++ph) {
            f32x4 acc[4][4];
#pragma unroll
            for (int pb = 0; pb < 4; ++pb)
#pragma unroll
                for (int db = 0; db < 4; ++db) acc[pb][db] = (f32x4){0.f, 0.f, 0.f, 0.f};
#pragma unroll
            for (int kq = 0; kq < 4; ++kq) {
                bf16x8 af[4], bfr[4];
#pragma unroll
                for (int db = 0; db < 4; ++db) af[db] = *(const LAS bf16x8*)(vT + (16 * db + fr) * 136 + 32 * kq + 8 * fq);
#pragma unroll
                for (int pb = 0; pb < 4; ++pb) bfr[pb] = *(const bf16x8*)(Wsb + (size_t)(g * 128 + 64 * ph + 16 * pb + fr) * 128 + 32 * kq + 8 * fq);
#pragma unroll
                for (int pb = 0; pb < 4; ++pb)
#pragma unroll
                    for (int db = 0; db < 4; ++db) acc[pb][db] = __builtin_amdgcn_mfma_f32_16x16x32_bf16(af[db], bfr[pb], acc[pb][db], 0, 0, 0);
            }
#pragma unroll
            for (int pb = 0; pb < 4; ++pb) { const int p = 64 * ph + 16 * pb + fr; const float bias = bs[g * 128 + p]; const size_t row = row0 + p;
#pragma unroll
                for (int db = 0; db < 4; ++db) { const int d = 16 * db + 4 * fq; const v2u uu = *(const v2u*)(P + row * INW + 768 + 64 * g + d);
                    v2u o; o.x = pk2(bflo(uu.x) * (acc[pb][db][0] + bias), bfhi(uu.x) * (acc[pb][db][1] + bias)); o.y = pk2(bflo(uu.y) * (acc[pb][db][2] + bias), bfhi(uu.y) * (acc[pb][db][3] + bias));
                    *(v2u*)(MIX + row * DM + 512 + 64 * g + d) = o; } }
        }
        LDS_WAIT(); asm volatile("" ::: "memory");
    }
}

__device__ __forceinline__ void pool_phase(const bf16* P, bf16* MIX, const bf16* WpT  , const float* pscale  , LAS unsigned char* lds, int wave, int gw, int NGW, int lane) {
    const int fr = lane & 15, fq = lane >> 4;
    LAS unsigned char* img = lds + wave * 16896;
    for (int tb = gw; tb < MTOK / 16; tb += NGW) {
        const int r0 = tb * 16; const int b = r0 / TPB, t0 = r0 - b * TPB; const int tt0 = (t0 < SEQ) ? t0 : t0 - SEQ, L = (t0 < SEQ) ? SEQ : CTXL;
        const bf16* seg = P + (size_t)(r0 - tt0) * INW + 1280;
#pragma unroll
        for (int it = 0; it < 16; ++it) { const int idx = it * 64 + lane, row = idx >> 5, pc = idx & 31;
            int tp = tt0 - 8 + row; tp = tp < 0 ? 0 : (tp > L - 1 ? L - 1 : tp);
            *(LAS v4u*)(img + row * 528 + pc * 16) = *(const v4u*)(seg + (size_t)tp * INW + 8 * pc); }
        LDS_WAIT(); asm volatile("" ::: "memory");
        const int tt = tt0 + fr; const int r = r0 + fr;
#pragma unroll 1
        for (int gi = 0; gi < 4; ++gi) {
            const int w = 2 << gi, left = w >> 1, right = w - 1 - left;
            int lo = tt - left; if (lo < 0) lo = 0; int hi = tt + right; if (hi > L - 1) hi = L - 1;
            const float rc = 1.0f / (float)(hi - lo + 1);
            bf16x8 yf[2];
#pragma unroll
            for (int ks = 0; ks < 2; ++ks) {
                const LAS unsigned char* src = img + (64 * gi + 32 * ks + 8 * fq) * 2;
                float sum[8];
#pragma unroll
                for (int i = 0; i < 8; ++i) sum[i] = 0.f;
                for (int tp = lo; tp <= hi; ++tp) { const v4u raw = *(const LAS v4u*)(src + (tp - tt0 + 8) * 528);
                    sum[0] += bflo(raw.x); sum[1] += bfhi(raw.x); sum[2] += bflo(raw.y); sum[3] += bfhi(raw.y); sum[4] += bflo(raw.z); sum[5] += bfhi(raw.z); sum[6] += bflo(raw.w); sum[7] += bfhi(raw.w); }
                const v4u own = *(const LAS v4u*)(src + (fr + 8) * 528);
                v4u pkd; pkd.x = pk2(sum[0] * rc - bflo(own.x), sum[1] * rc - bfhi(own.x)); pkd.y = pk2(sum[2] * rc - bflo(own.y), sum[3] * rc - bfhi(own.y));
                pkd.z = pk2(sum[4] * rc - bflo(own.z), sum[5] * rc - bfhi(own.z)); pkd.w = pk2(sum[6] * rc - bflo(own.w), sum[7] * rc - bfhi(own.w));
                yf[ks] = __builtin_bit_cast(bf16x8, pkd);
            }
#pragma unroll
            for (int eb = 0; eb < 4; ++eb) {
                f32x4 acc = (f32x4){0.f, 0.f, 0.f, 0.f};
#pragma unroll
                for (int ks = 0; ks < 2; ++ks) { const bf16x8 af = *(const bf16x8*)(WpT + (size_t)(gi * 64 + 16 * eb + fr) * 64 + 32 * ks + 8 * fq); acc = __builtin_amdgcn_mfma_f32_16x16x32_bf16(af, yf[ks], acc, 0, 0, 0); }
                const int e = 16 * eb + 4 * fq; const f32x4 psc = *(const f32x4*)(pscale + 64 * gi + e);
                v2u o; o.x = pk2(acc[0] * psc[0], acc[1] * psc[1]); o.y = pk2(acc[2] * psc[2], acc[3] * psc[3]);
                *(v2u*)(MIX + (size_t)r * DM + 768 + 64 * gi + e) = o;
            }
        }
        LDS_WAIT(); asm volatile("" ::: "memory");
    }
}

__device__ __forceinline__ void fixup_phase(bf16* A, const float* SB, const float* cw, int skip_ctx, int gw, int NGW, int lane) {
    for (int item = gw; item < NTILE * 8; item += NGW) {
        const int pm = item >> 3, e = item & 7; const int b = pm / 9, j = pm - 9 * b;
        if (skip_ctx && j == 8) continue;
        int npm = -1, ne = 0;
        if ((e & 1) == 0) { if (e > 0) { npm = pm; ne = e - 1; } else if (j >= 1 && j <= 7) { npm = pm - 1; ne = 7; } }
        else { if (e < 7) { npm = pm; ne = e + 1; } else if (j <= 6) { npm = pm + 1; ne = 0; } }
        if (npm < 0) continue;
        const float* own = SB + (size_t)(pm * 8 + e) * 4 * 2816; const float* nbr = SB + (size_t)(npm * 8 + ne) * 4 * 2816;
        const float* wt = cw + ((e & 1) ? 2 * FF2 : 0);
        bf16* arow = A + (size_t)(pm * 256 + 64 * (e >> 1) + ((e & 1) ? 63 : 0)) * FF;
#pragma unroll 4
        for (int i = lane; i < FF / 4; i += 64) { const int jj = 4 * i;
            const f32x4 zg = *(const f32x4*)(own + 2 * 2816 + jj) + *(const f32x4*)(wt + jj) * *(const f32x4*)(nbr + jj);
            const f32x4 zv = *(const f32x4*)(own + 3 * 2816 + jj) + *(const f32x4*)(wt + FF + jj) * *(const f32x4*)(nbr + 2816 + jj);
            v2u o; o.x = pk2(pg8::silu_f(zg[0]) * zv[0], pg8::silu_f(zg[1]) * zv[1]); o.y = pk2(pg8::silu_f(zg[2]) * zv[2], pg8::silu_f(zg[3]) * zv[3]);
            *(v2u*)(arow + jj) = o; }
    }
}
#ifndef REP_LIGHT
#define REP_LIGHT 1
#endif
#ifndef REP_ATTN
#define REP_ATTN 1
#endif
#ifndef REP_SYNC
#define REP_SYNC 1
#endif
__global__ void __launch_bounds__(512, 2) mk_fwd(Args args) {
    extern __shared__ __attribute__((aligned(16))) unsigned char lds[];
    cg::grid_group grid = cg::this_grid();
    LAS unsigned char* l3 = (LAS unsigned char*)lds;
    int tid = pg8::opaque_tid(), lane = tid & 63, wave = __builtin_amdgcn_readfirstlane(tid >> 6);
    const int G = gridDim.x, bx = blockIdx.x;
    const int vcu = (G % 8 == 0) ? (bx % 8) * (G / 8) + bx / 8 : bx;
    int gw = vcu * 8 + wave; const int NGW = G * 8;
    unsigned char* ws = args.ws;
#define RELAUNDER() do { ws = args.ws; asm volatile("" : "+s"(ws)); tid = pg8::opaque_tid(); lane = tid & 63; wave = __builtin_amdgcn_readfirstlane(tid >> 6); gw = vcu * 8 + wave; } while (0)
    float* PRM = (float*)(ws + WS_PRM);
#define GSYNC() do { for (int rs_ = 0; rs_ < REP_SYNC; ++rs_) xcd_barrier(xbar); RELAUNDER(); } while (0)
#define MOD ((float*)(ws + WS_MOD))
#define WSB ((bf16*)(ws + WS_WSB))
#define WPT ((bf16*)(ws + WS_WPT))
#define SB ((float*)(ws + WS_SB))
#define X ((bf16*)(ws + WS_X))
#define H ((bf16*)(ws + WS_H))
#define P ((bf16*)(ws + WS_P))
#define MIX ((bf16*)(ws + WS_MIX))
#define A ((bf16*)(ws + WS_A))
#define x_in (args.in[0])
#define ctx_in (args.in[2])
#define PRML ((const float*)(ws + WS_PRM) + (size_t)l * PRM_L)

    if (bx == 0) for (int i = tid; i < XCD_BAR_WORDS; i += 512) ((unsigned*)(ws + WS_BAR))[i] = 0u;
    if (tid < 2) ((volatile LAS unsigned*)(l3 + LDS_BYTES - 64))[tid] = 0u;
    __syncthreads();
#if !defined(ONLY) || ONLY==1
    mod_phase(args, l3, tid);
#endif

    {
        LAS float* scr = (LAS float*)(l3 + wave * 16384);
        constexpr int I_IN = 16 * 48, I_OUT = 16 * 32, I_UP = 16 * 176, I_DN = 44 * 32, I_L = I_IN + I_OUT + I_UP + I_DN;
        for (int it = gw; it < NLAYER * I_L; it += NGW) {
            const int l = it / I_L; int r = it - l * I_L;
            if (r < I_IN) { p0_transpose_item(args.in[7] + (size_t)l * DM * INW, DM, INW, (bf16*)(ws + WS_WIN) + (size_t)l * INW * DM, false, scr, r, lane); continue; } r -= I_IN;
            if (r < I_OUT) { p0_transpose_item(args.in[14] + (size_t)l * DM * DM, DM, DM, (bf16*)(ws + WS_WOUT) + (size_t)l * DM * DM, false, scr, r, lane); continue; } r -= I_OUT;
            if (r < I_UP) { p0_transpose_item(args.in[16] + (size_t)l * DM * FF2, DM, FF2, (bf16*)(ws + WS_WUP) + (size_t)l * FF2 * DM, true, scr, r, lane); continue; } r -= I_UP;
            p0_transpose_item(args.in[19] + (size_t)l * FF * DM, FF, DM, (bf16*)(ws + WS_WDN) + (size_t)l * DM * FF, false, scr, r, lane);
        }
        const int gt = gw * 64 + lane, NGT = NGW * 64;
        for (int l = 0; l < NLAYER; ++l) { float* pl = PRM + (size_t)l * PRM_L;
            for (int i = gt; i < 1024; i += NGT) { pl[PRM_N1G + i] = args.in[6][l * 1024 + i]; pl[PRM_N2G + i] = args.in[15][l * 1024 + i]; }
            for (int i = gt; i < 64; i += NGT) { pl[PRM_QG + i] = args.in[8][l * 64 + i]; pl[PRM_KG + i] = args.in[9][l * 64 + i]; }
            for (int i = gt; i < 512; i += NGT) pl[PRM_BS + i] = args.in[11][l * 512 + i];
            for (int i = gt; i < 256; i += NGT) pl[PRM_PSC + i] = args.in[13][l * 256 + i];
            for (int i = gt; i < 3 * FF2; i += NGT) pl[PRM_CW + i] = args.in[17][(size_t)l * 3 * FF2 + i];
            for (int i = gt; i < FF2; i += NGT) pl[PRM_CB + i] = args.in[18][(size_t)l * FF2 + i]; }
        for (int i = gt; i < 1024; i += NGT) PRM[NLAYER * PRM_L + i] = args.in[20][i];
        for (int i = gt; i < NLAYER * 4 * 128 * 128; i += NGT) WSB[i] = (bf16)(pk2(args.in[10][i], 0.f) & 0xffffu);
        for (int i = gt; i < NLAYER * 4 * 64 * 64; i += NGT) { const int d = i & 63, e = (i >> 6) & 63, lg = i >> 12; WPT[i] = (bf16)(pk2(args.in[12][(size_t)lg * 4096 + d * 64 + e], 0.f) & 0xffffu); }
    }
    grid.sync(); RELAUNDER();
    XcdBarrier xbar = xcd_barrier_post((unsigned*)(ws + WS_BAR), (volatile LAS unsigned*)(l3 + LDS_BYTES - 64));

    for (int l = 0; l < NLAYER; ++l) {
        const int last = (l == NLAYER - 1);
#define mod (MOD + (size_t)l * 33 * MODW)
#define Win_t ((const bf16*)(ws + WS_WIN) + (size_t)l * INW * DM)
#define Wout_t ((const bf16*)(ws + WS_WOUT) + (size_t)l * DM * DM)
#define Wup_t ((const bf16*)(ws + WS_WUP) + (size_t)l * FF2 * DM)
#define Wdn_t ((const bf16*)(ws + WS_WDN) + (size_t)l * DM * FF)
#if !defined(ONLY) || ONLY==2
        for (int rep_ = 0; rep_ < REP_LIGHT; ++rep_)
        if (l == 0) norm_phase(x_in, ctx_in, nullptr, 1, PRML + PRM_N1G, mod, 0, 1024, H, 0, gw, NGW, lane);
        else norm_phase_b(X, PRML + PRM_N1G, mod, 0, 1024, H, 0, gw, NGW, lane);
#endif

        GSYNC();
#if !defined(ONLY) || ONLY==3
        { pg8::Gemm g{H, Win_t, MTOK, INW, DM}; pg8::TileOrder S; S.init(NTILE, INW, G, bx, 0);
          pg8::EpiBf16<0> E{P, INW, nullptr, 0, 0, 1.f};
          pg8::gemm_phase<pg8::EpiBf16<0>, pg8::TileOrder, true, true>(l3, g, S, E); }
#endif

        GSYNC();
#if !defined(ONLY) || ONLY==4
        normrope_phase(P, PRML + PRM_KG, gw, NGW, lane);
#endif

#if !defined(ONLY) || ONLY==5
        for (int rep_ = 0; rep_ < REP_LIGHT; ++rep_) {
        sgu_phase(P, MIX, WSB + (size_t)l * 4 * 128 * 128, PRML + PRM_BS, l3, wave, gw, NGW, lane);
#endif

#if !defined(ONLY) || ONLY==6
        pool_phase(P, MIX, WPT + (size_t)l * 4 * 64 * 64, PRML + PRM_PSC, l3, wave, gw, NGW, lane); }
#endif

        GSYNC();
        {
#if !defined(ONLY) || ONLY==7
            for (int rep_ = 0; rep_ < REP_ATTN; ++rep_)
            for (int bh = vcu; bh < NB * 8; bh += G) {
                const int b = bh >> 3, h = bh & 7;
                const attn_body::bf16* Pb = (const attn_body::bf16*)P + (size_t)b * TPB * INW;
                attn_body::bf16* Ob = (attn_body::bf16*)MIX + (size_t)b * TPB * DM + h * 64;
                const attn_body::bf16* Kb = Pb + 512 + (h >> 2) * 64; const attn_body::bf16* Vb = Pb + 640 + (h >> 2) * 64;
                const int nu = last ? 8 : 9;
                for (int qb = 0; qb < nu; ++qb) {
                    const attn_body::bf16* Qu = Pb + (size_t)(qb * 256) * INW + h * 64;
                    if (qb < 8) attn_body::attn_unit<8>(Qu, Kb, Vb, Ob + (size_t)(qb * 256) * DM, (SEQ + CTXL) / 64, (char*)lds, PRML + PRM_QG, qb * 256);
                    else attn_body::attn_unit<8>(Qu, Kb + (size_t)SEQ * INW, Vb + (size_t)SEQ * INW, Ob + (size_t)(qb * 256) * DM, CTXL / 64, (char*)lds, PRML + PRM_QG, -1);
                }
            }
#endif

        }
        GSYNC();
#if !defined(ONLY) || ONLY==8
        { pg8::Gemm g{MIX, Wout_t, MTOK, DM, DM}; pg8::TileOrder S; S.init(last ? NB * 8 : NTILE, DM, G, bx, last);
          pg8::EpiRes E{x_in, ctx_in, X, mod + 2048, l == 0};
          pg8::gemm_phase<pg8::EpiRes, pg8::TileOrder, true, true>(l3, g, S, E); }
#endif

        GSYNC();
        for (int rep_ = 0; rep_ < REP_LIGHT; ++rep_)
        norm_phase_b(X, PRML + PRM_N2G, mod, 3072, 4096, H, last, gw, NGW, lane);
        GSYNC();
#if !defined(ONLY) || ONLY==9
        { pg8::Gemm g{H, Wup_t, MTOK, FF2, DM}; pg8::TileOrder S; S.init(last ? NB * 8 : NTILE, FF2, G, bx, last);
          pg8::EpiUpGate E{A, SB, PRML + PRM_CW, PRML + PRM_CB, (LAS float*)(l3 + 131072 + 4096)};
          pg8::gemm_phase<pg8::EpiUpGate, pg8::TileOrder, true, true>(l3, g, S, E); }
#endif

        GSYNC();
#if !defined(ONLY) || ONLY==10
        for (int rep_ = 0; rep_ < REP_LIGHT; ++rep_)
        fixup_phase(A, SB, PRML + PRM_CW, last, gw, NGW, lane);
#endif

        GSYNC();
#if !defined(ONLY) || ONLY==11
        { pg8::Gemm g{A, Wdn_t, MTOK, DM, FF}; pg8::TileOrder S; S.init(last ? NB * 8 : NTILE, DM, G, bx, last);
          pg8::EpiRes E{x_in, ctx_in, X, mod + 5120, 0};
          pg8::gemm_phase<pg8::EpiRes, pg8::TileOrder, true, true>(l3, g, S, E); }
#endif

        GSYNC();
    }
    for (int rep_ = 0; rep_ < REP_LIGHT; ++rep_)
    final_norm_phase(X, (const float*)(ws + WS_PRM) + NLAYER * PRM_L, args.out, gw, NGW, lane);
}

extern "C" void kernel_launch(void* const* d_in, const int* in_sizes, int n_in, void* d_out, int out_size, void* d_ws, size_t ws_size, hipStream_t stream) {
    static int grid = 0;
    if (grid == 0) {
        if (n_in != 21 || in_sizes[0] != NB * SEQ * DM || out_size != NB * SEQ * DM || ws_size < WS_END) { fprintf(stderr, "kernel_launch: unexpected shapes (n_in %d, in0 %d, out %d, ws %zu); nothing launched\n", n_in, n_in > 0 ? in_sizes[0] : -1, out_size, ws_size); grid = -1; return; }
        int dev = 0, cus = 0, per_cu = 0;
        if (hipGetDevice(&dev) != hipSuccess || hipDeviceGetAttribute(&cus, hipDeviceAttributeMultiprocessorCount, dev) != hipSuccess) { grid = -1; return; }
        if (hipFuncSetAttribute((const void*)mk_fwd, hipFuncAttributeMaxDynamicSharedMemorySize, LDS_BYTES) != hipSuccess) { fprintf(stderr, "kernel_launch: hipFuncSetAttribute failed\n"); grid = -1; return; }
        if (hipOccupancyMaxActiveBlocksPerMultiprocessor(&per_cu, (const void*)mk_fwd, 512, LDS_BYTES) != hipSuccess || per_cu < 1) { fprintf(stderr, "kernel_launch: occupancy query says %d\n", per_cu); per_cu = 1; }
        (void)hipGetLastError();
        grid = cus * 1;
    }
    if (grid < 0) return;
    Args a{};
    for (int i = 0; i < 21; ++i) a.in[i] = (const float*)d_in[i];
    a.out = (float*)d_out; a.ws = (unsigned char*)d_ws;
    void* kargs[] = {&a};
    hipError_t e = hipLaunchCooperativeKernel((const void*)mk_fwd, dim3(grid), dim3(512), kargs, LDS_BYTES, stream);
    if (e != hipSuccess) fprintf(stderr, "cooperative launch failed: %s (grid %d)\n", hipGetErrorString(e), grid);
}
```

```cpp
#include <hip/hip_runtime.h>
#include <hip/hip_cooperative_groups.h>
#include <hip/hip_bf16.h>
#include <cstdio>
#include <cstdint>
#include <cmath>
namespace cg = cooperative_groups;
namespace pg8 { __device__ __forceinline__ int opaque_tid() { int t = threadIdx.x; asm volatile("" : "+v"(t)); return t; } }
namespace pg8 {
#define PG8_LAS __attribute__((address_space(3)))
typedef unsigned short bf16_t;
typedef short bf16x8 __attribute__((ext_vector_type(8)));
typedef float f32x4 __attribute__((ext_vector_type(4)));
typedef unsigned u32x4 __attribute__((ext_vector_type(4)));
constexpr int BM = 256, BK = 64, HALF = 128, HTB = HALF * BK * 2  , STAGE_BYTES = 8 * HTB, NXCD = 8, WGM = 4;

__host__ __device__ __forceinline__ int lds_byte(int r, int c) { const int st = (r >> 4) * 2 + (c >> 5), rr = r & 15, cc = c & 31, ob = rr * 64 + cc * 2; return st * 1024 + (ob ^ (((ob >> 9) & 1) << 5)); }
__host__ __device__ __forceinline__ void stage_rc(int b, int& R, int& C) { const int st = b / 1024, sb = b % 1024, swz = sb ^ (((sb >> 9) & 1) << 5); R = (st >> 1) * 16 + swz / 64; C = (st & 1) * 32 + (swz % 64) / 2; }
__host__ __device__ __forceinline__ int perm32(int rho) { const int n = rho >> 4, i = rho & 15; return 8 * (i >> 2) + 4 * n + (i & 3); }

struct Unit { int pm, pn; };
struct Gemm { const bf16_t* A; const bf16_t* Bt; int M, N, K; };

struct StaticOrder {
    int nM, nN, nwg, G, c;
    __host__ __device__ void init(int M, int N, int G_, int c_) { nM = M / BM; nN = N / BM; nwg = nM * nN; G = G_; c = c_; }
    __host__ __device__ bool next(int i, Unit& u) const {
        const long L = (long)i * G + c; if (L >= nwg) return false;
        int wgid = (int)L; { const int q = nwg / NXCD, r = nwg % NXCD, xcd = wgid % NXCD, off = wgid / NXCD; wgid = (xcd < r ? xcd * (q + 1) : r * (q + 1) + (xcd - r) * q) + off; }
        const int nig = WGM * nN, gid = wgid / nig, fm = gid * WGM, gsz = (nM - fm) < WGM ? (nM - fm) : WGM;
        u.pm = fm + ((wgid % nig) % gsz); u.pn = (wgid % nig) / gsz; return true;
    }
    __device__ __forceinline__ void a_ready(const Unit&) const {}
    __device__ __forceinline__ void done(const Unit&) const {}
};

__device__ __forceinline__ unsigned cvt_pk_bf16(float lo, float hi) { unsigned r; asm volatile("v_cvt_pk_bf16_f32 %0, %1, %2" : "=v"(r) : "v"(lo), "v"(hi)); return r; }
typedef float f32x2 __attribute__((ext_vector_type(2)));
__device__ __forceinline__ f32x2 gelu_pk(f32x2 v) {
    const f32x2 av = __builtin_elementwise_abs(v), d = av * 0.2316418882f + 1.0f;
    f32x2 t; t.x = __builtin_amdgcn_rcpf(d.x); t.y = __builtin_amdgcn_rcpf(d.y);
    f32x2 q = t * 0.5307027145f + (-0.7265760135f); q = q * t + 0.7107068705f; q = q * t + (-0.142248368f); q = q * t + 0.127414796f; q = q * t;
    const f32x2 s = (v * v) * (-0.72134752044f);
    f32x2 e; e.x = __builtin_amdgcn_exp2f(s.x); e.y = __builtin_amdgcn_exp2f(s.y);
    const f32x2 m = v * (q * e), r = v - m;
    f32x2 o; o.x = v.x < 0.f ? m.x : r.x; o.y = v.y < 0.f ? m.y : r.y; return o;
}

template <int ACT  > struct EpiBf16 {
    static constexpr bool PERM = true, AFTER_DRAIN = false; static_assert(ACT == 0 || ACT == 1, "EpiBf16: ACT is 0 (none) or 1 (gelu_pk)");
    bf16_t* O; int ldc; const float* bias; int split_cols; size_t split_stride; float scale0;
    __device__ __forceinline__ void operator()(const f32x4 (&acc)[2][2][4][2], const Unit& u, int wr, int wc, int fr, int fq) const {
        const int row0 = u.pm * BM + wr * 64 + fr; int colt = u.pn * BM; bf16_t* base = O;
        float sc = 1.f; if (split_cols) { const int t = colt / split_cols; base += (size_t)t * split_stride; colt -= t * split_cols; if (t == 0) sc = scale0; }
        const int col0 = colt + wc * 32 + 8 * fq, bcol0 = u.pn * BM + wc * 32 + 8 * fq;
        f32x4 bv[2][2];
#pragma unroll
        for (int bj = 0; bj < 2; ++bj)
#pragma unroll
            for (int n = 0; n < 2; ++n) bv[bj][n] = bias ? *(const f32x4*)(bias + bcol0 + bj * HALF + 4 * n) : (f32x4){0.f, 0.f, 0.f, 0.f};
#pragma unroll
        for (int ai = 0; ai < 2; ++ai)
#pragma unroll
            for (int m = 0; m < 4; ++m) { bf16_t* rowp = base + (size_t)(row0 + ai * HALF + m * 16) * ldc + col0;
#pragma unroll
                for (int bj = 0; bj < 2; ++bj) { f32x4 v0 = acc[ai][bj][m][0] + bv[bj][0], v1 = acc[ai][bj][m][1] + bv[bj][1];
                    if (ACT == 1) { f32x2 a = gelu_pk((f32x2){v0[0], v0[1]}), b = gelu_pk((f32x2){v0[2], v0[3]}), c = gelu_pk((f32x2){v1[0], v1[1]}), d = gelu_pk((f32x2){v1[2], v1[3]});
                        v0 = (f32x4){a.x, a.y, b.x, b.y}; v1 = (f32x4){c.x, c.y, d.x, d.y}; }
                    v0 = v0 * sc; v1 = v1 * sc; u32x4 w; w.x = cvt_pk_bf16(v0[0], v0[1]); w.y = cvt_pk_bf16(v0[2], v0[3]); w.z = cvt_pk_bf16(v1[0], v1[1]); w.w = cvt_pk_bf16(v1[2], v1[3]);
                    *(u32x4*)(rowp + bj * HALF) = w; } }
    }
};
__device__ __forceinline__ unsigned cvtpk2(float lo, float hi) { typedef float f2 __attribute__((ext_vector_type(2))); typedef __bf16 b2 __attribute__((ext_vector_type(2))); f2 v = {lo, hi}; b2 b = __builtin_convertvector(v, b2); return __builtin_bit_cast(unsigned, b); }
template <int CTRL> __device__ __forceinline__ float dppz(float v) { return __builtin_bit_cast(float, __builtin_amdgcn_update_dpp(0, __builtin_bit_cast(int, v), CTRL, 0xf, 0xf, true)); }
template <int CTRL> __device__ __forceinline__ f32x4 dppz4(f32x4 v) { f32x4 r; r[0] = dppz<CTRL>(v[0]); r[1] = dppz<CTRL>(v[1]); r[2] = dppz<CTRL>(v[2]); r[3] = dppz<CTRL>(v[3]); return r; }
#ifdef V_NOSILU
__device__ __forceinline__ float silu_f(float x) { return x; }
#else
__device__ __forceinline__ float silu_f(float x) { return x * __builtin_amdgcn_rcpf(1.0f + __builtin_amdgcn_exp2f(-1.4426950408889634f * x)); }
#endif

struct EpiRes {
    static constexpr bool PERM = true, AFTER_DRAIN = false;
    const float* xin; const float* ctxin; bf16_t* X; const float* gate; int from_inputs;
    __device__ __forceinline__ void operator()(const f32x4 (&acc)[2][2][4][2], const Unit& u, int wr, int wc, int fr, int fq) const {
        const int b = u.pm / 9, j = u.pm - 9 * b, midx = (j == 8) ? 32 : b;
        bf16_t* xt = X + (size_t)u.pm * 256 * 1024;
        const int col0 = u.pn * BM + wc * 32 + 8 * fq;
        f32x4 gv[2][2];
#pragma unroll
        for (int bj = 0; bj < 2; ++bj)
#pragma unroll
            for (int n = 0; n < 2; ++n) gv[bj][n] = *(const f32x4*)(gate + (size_t)midx * 6144 + col0 + bj * HALF + n * 4);
        if (from_inputs) {
            const float* basef = (j < 8 ? xin + (size_t)(b * 2048 + 256 * j) * 1024 : ctxin + (size_t)b * 256 * 1024);
#pragma unroll
            for (int ai = 0; ai < 2; ++ai) {
                f32x4 fb[4][2][2];
#pragma unroll
                for (int m = 0; m < 4; ++m)
#pragma unroll
                    for (int bj = 0; bj < 2; ++bj) { const float* p = basef + (unsigned)((ai * HALF + wr * 64 + m * 16 + fr) * 1024 + col0) + bj * HALF; fb[m][bj][0] = *(const f32x4*)p; fb[m][bj][1] = *(const f32x4*)(p + 4); }
                asm volatile("" ::: "memory");
#pragma unroll
                for (int m = 0; m < 4; ++m) { const unsigned off = (unsigned)((ai * HALF + wr * 64 + m * 16 + fr) * 1024 + col0);
#pragma unroll
                    for (int bj = 0; bj < 2; ++bj) {
                        const f32x4 o0 = fb[m][bj][0] + gv[bj][0] * acc[ai][bj][m][0], o1 = fb[m][bj][1] + gv[bj][1] * acc[ai][bj][m][1];
                        u32x4 w; w.x = cvtpk2(o0[0], o0[1]); w.y = cvtpk2(o0[2], o0[3]); w.z = cvtpk2(o1[0], o1[1]); w.w = cvtpk2(o1[2], o1[3]);
                        *(u32x4*)(xt + off + bj * HALF) = w; } }
                asm volatile("" ::: "memory");
            }
        } else {
            u32x4 rb[2][4][2];
#pragma unroll
            for (int ai = 0; ai < 2; ++ai)
#pragma unroll
                for (int m = 0; m < 4; ++m)
#pragma unroll
                    for (int bj = 0; bj < 2; ++bj) rb[ai][m][bj] = *(const u32x4*)(xt + (unsigned)((ai * HALF + wr * 64 + m * 16 + fr) * 1024 + col0) + bj * HALF);
            asm volatile("" ::: "memory");
#pragma unroll
            for (int ai = 0; ai < 2; ++ai)
#pragma unroll
                for (int m = 0; m < 4; ++m) { const unsigned off = (unsigned)((ai * HALF + wr * 64 + m * 16 + fr) * 1024 + col0);
#pragma unroll
                    for (int bj = 0; bj < 2; ++bj) { const u32x4 r = rb[ai][m][bj];
                        const f32x4 b0 = (f32x4){__uint_as_float(r.x << 16), __uint_as_float(r.x & 0xffff0000u), __uint_as_float(r.y << 16), __uint_as_float(r.y & 0xffff0000u)};
                        const f32x4 b1 = (f32x4){__uint_as_float(r.z << 16), __uint_as_float(r.z & 0xffff0000u), __uint_as_float(r.w << 16), __uint_as_float(r.w & 0xffff0000u)};
                        const f32x4 o0 = b0 + gv[bj][0] * acc[ai][bj][m][0], o1 = b1 + gv[bj][1] * acc[ai][bj][m][1];
                        u32x4 w; w.x = cvtpk2(o0[0], o0[1]); w.y = cvtpk2(o0[2], o0[3]); w.z = cvtpk2(o1[0], o1[1]); w.w = cvtpk2(o1[2], o1[3]);
                        *(u32x4*)(xt + off + bj * HALF) = w; } }
        }
    }
};

struct EpiUpGate {
    static constexpr bool PERM = true, AFTER_DRAIN = false;
    bf16_t* A; float* SB; const float* cw; const float* cb; PG8_LAS float* cl  ;
    __device__ __forceinline__ void operator()(const f32x4 (&acc)[2][2][4][2], const Unit& u, int wr, int wc, int fr, int fq) const {
        const int jc = u.pn * 128 + wc * 32 + 8 * fq;
        PG8_LAS float* cwv = cl + (wr * 4 + wc) * 256;
        { const int v = fr + 16 * fq, hv = v >> 5, k = (v >> 3) & 3, c4 = v & 7;
          const float* src = (k < 3 ? cw + k * 5632 : cb) + hv * 2816 + u.pn * 128 + wc * 32 + 4 * c4;
          *(PG8_LAS f32x4*)(cwv + v * 4) = *(const f32x4*)src;
          asm volatile("s_waitcnt lgkmcnt(0)" ::: "memory"); }
#define CWL(hv_, k_, n_) (*(const PG8_LAS f32x4*)(cwv + ((hv_) * 4 + (k_)) * 32 + 8 * fq + 4 * (n_)))
#if 1
#pragma unroll
        for (int n = 0; n < 2; ++n) {
            const int j0 = jc + 4 * n;
            const f32x4 w0g = CWL(0, 0, n), w1g = CWL(0, 1, n), w2g = CWL(0, 2, n), bg = CWL(0, 3, n);
            const f32x4 w0v = CWL(1, 0, n), w1v = CWL(1, 1, n), w2v = CWL(1, 2, n), bv = CWL(1, 3, n);
#pragma unroll
            for (int ai = 0; ai < 2; ++ai) {
                float* sb = SB + ((size_t)(u.pm * 8 + 2 * (2 * ai + wr)) * 4) * 2816 + j0;
                { const f32x4 zg = acc[ai][0][0][n], zv = acc[ai][1][0][n];
                  const f32x4 cgv = w1g * zg + w2g * dppz4<0x101>(zg) + bg, cvv = w1v * zv + w2v * dppz4<0x101>(zv) + bv;
                  if (fr == 0) { *(f32x4*)(sb) = zg; *(f32x4*)(sb + 2816) = zv; *(f32x4*)(sb + 2 * 2816) = cgv; *(f32x4*)(sb + 3 * 2816) = cvv; } }
                { const f32x4 zg = acc[ai][0][3][n], zv = acc[ai][1][3][n];
                  const f32x4 cgv = w1g * zg + w0g * dppz4<0x111>(zg) + bg, cvv = w1v * zv + w0v * dppz4<0x111>(zv) + bv;
                  if (fr == 15) { float* sb1 = sb + 4 * 2816; *(f32x4*)(sb1) = zg; *(f32x4*)(sb1 + 2816) = zv; *(f32x4*)(sb1 + 2 * 2816) = cgv; *(f32x4*)(sb1 + 3 * 2816) = cvv; } }
                asm volatile("" ::: "memory"); __builtin_amdgcn_sched_barrier(0);
            }
        }
#endif
        unsigned pk[2][4][2];
#pragma unroll
        for (int n = 0; n < 2; ++n) {
            const int j0 = jc + 4 * n;
            const f32x4 w0g = CWL(0, 0, n), w1g = CWL(0, 1, n), w2g = CWL(0, 2, n), bg = CWL(0, 3, n);
            const f32x4 w0v = CWL(1, 0, n), w1v = CWL(1, 1, n), w2v = CWL(1, 2, n), bv = CWL(1, 3, n);
#pragma unroll
            for (int ai = 0; ai < 2; ++ai) {
#pragma unroll
                for (int m = 0; m < 4; ++m) {
                    const f32x4 zg = acc[ai][0][m][n], zv = acc[ai][1][m][n];
#ifdef V_NODPP
                    f32x4 pg = zg, pv = zv, ng = zg, nv = zv;
#else
                    f32x4 pg = dppz4<0x111>(zg), pv = dppz4<0x111>(zv), ng = dppz4<0x101>(zg), nv = dppz4<0x101>(zv);
                    if (m > 0) { pg += dppz4<0x10F>(acc[ai][0][m - 1][n]); pv += dppz4<0x10F>(acc[ai][1][m - 1][n]); }
                    if (m < 3) { ng += dppz4<0x11F>(acc[ai][0][m + 1][n]); nv += dppz4<0x11F>(acc[ai][1][m + 1][n]); }
#endif
                    const f32x4 cgv = w1g * zg + w0g * pg + w2g * ng + bg, cvv = w1v * zv + w0v * pv + w2v * nv + bv;
                    const int rho = 2 * ai + wr;
#if 0
                    if ((m == 0 && fr == 0) || (m == 3 && fr == 15)) {
                        float* sb = SB + ((size_t)(u.pm * 8 + 2 * rho + (m == 3 ? 1 : 0)) * 4) * 2816 + j0;
                        *(f32x4*)(sb) = zg; *(f32x4*)(sb + 2816) = zv; *(f32x4*)(sb + 2 * 2816) = cgv; *(f32x4*)(sb + 3 * 2816) = cvv;
                    }
#endif
                    const unsigned lo = cvtpk2(silu_f(cgv[0]) * cvv[0], silu_f(cgv[1]) * cvv[1]), hi = cvtpk2(silu_f(cgv[2]) * cvv[2], silu_f(cgv[3]) * cvv[3]);
                    if (n == 0) { pk[ai][m][0] = lo; pk[ai][m][1] = hi; }
                    else { u32x4 w; w.x = pk[ai][m][0]; w.y = pk[ai][m][1]; w.z = lo; w.w = hi;
                        *(u32x4*)(A + (size_t)(u.pm * BM + ai * HALF + wr * 64 + m * 16 + fr) * 2816 + jc) = w; }
                    if (m & 1) { asm volatile("" ::: "memory"); __builtin_amdgcn_sched_barrier(0); }
                }
            }
        }
    }
};
#undef CWL

struct TileOrder {
    int nM, nN, nwg, G, c, skip;
    __device__ void init(int nM_, int N, int G_, int c_, int skip_) { nM = nM_; nN = N / BM; nwg = nM * nN; G = G_; c = c_; skip = skip_; }
    __device__ bool next(int i, Unit& u) const {
        const long L = (long)i * G + c; if (L >= nwg) return false;
        int wgid = (int)L; { const int q = nwg / NXCD, r = nwg % NXCD, xcd = wgid % NXCD, off = wgid / NXCD; wgid = (xcd < r ? xcd * (q + 1) : r * (q + 1) + (xcd - r) * q) + off; }
        const int nig = WGM * nN, gid = wgid / nig, fm = gid * WGM, gsz = (nM - fm) < WGM ? (nM - fm) : WGM;
        int pm = fm + ((wgid % nig) % gsz); u.pn = (wgid % nig) / gsz;
        if (skip) pm = (pm >> 3) * 9 + (pm & 7);
        u.pm = pm; return true;
    }
    __device__ __forceinline__ void a_ready(const Unit&) const {}
    __device__ __forceinline__ void done(const Unit&) const {}
};
template <class Epi, class Sched, bool ALIGN_EPI = false, bool SP2 = false>
__device__ __forceinline__ void gemm_phase(PG8_LAS unsigned char* lds, const Gemm g, const Sched& S, const Epi& E) {
    const int tid = opaque_tid(), wid = __builtin_amdgcn_readfirstlane(tid >> 6), lane = tid & 63, wr = wid >> 2, wc = wid & 3, fr = lane & 15, fq = lane >> 4;
    const int K = g.K, nt = K / BK;
    unsigned voffA[2], voffB[2];
#pragma unroll
    for (int i = 0; i < 2; ++i) { int R, C; stage_rc(tid * 16 + i * 8192, R, C); const int Rb = Epi::PERM ? ((R & ~31) + perm32(R & 31)) : R;
        voffA[i] = (unsigned)(R * K + C) * 2u; voffB[i] = (unsigned)(Rb * K + C) * 2u; }
    const size_t kstep = (size_t)(BK * 2);
    const size_t hstep = (size_t)HALF * K * 2;
    const size_t tstep = 2 * hstep;
    const unsigned ldsw = (unsigned)wid * 1024u;
    const int aoff = lds_byte(wr * 64 + fr, fq * 8), boff = lds_byte(wc * 32 + fr, fq * 8);
#define PG8_SA(b, h) (((b) * 2 + (h)) * HTB)
#define PG8_SB(b, h) ((4 + (b) * 2 + (h)) * HTB)
#define PG8_STAGE(bufoff, gbase, voff) do { _Pragma("unroll") for (int _i = 0; _i < 2; ++_i) \
        __builtin_amdgcn_global_load_lds((const unsigned*)((const char*)(gbase) + (voff)[_i]), (PG8_LAS unsigned*)(lds + (bufoff) + ldsw + _i * 8192), 16, 0, 0); } while (0)
#define PG8_LDA(dst, b, h) do { _Pragma("unroll") for (int m = 0; m < 4; ++m) _Pragma("unroll") for (int k = 0; k < 2; ++k) dst[m][k] = *(const PG8_LAS bf16x8*)(lds + PG8_SA(b, h) + aoff + m * 2048 + k * 1024); } while (0)
#define PG8_LDB(dst, b, h) do { _Pragma("unroll") for (int n = 0; n < 2; ++n) _Pragma("unroll") for (int k = 0; k < 2; ++k) dst[n][k] = *(const PG8_LAS bf16x8*)(lds + PG8_SB(b, h) + boff + n * 2048 + k * 1024); } while (0)
#define PG8_MMA(ai, bj, At, Bt) do { __builtin_amdgcn_s_setprio(1); _Pragma("unroll") for (int m = 0; m < 4; ++m) _Pragma("unroll") for (int n = 0; n < 2; ++n) _Pragma("unroll") for (int k = 0; k < 2; ++k) \
        acc[ai][bj][m][n] = __builtin_amdgcn_mfma_f32_16x16x32_bf16(Bt[n][k], At[m][k], acc[ai][bj][m][n], 0, 0, 0); __builtin_amdgcn_s_setprio(0); } while (0)
#define PG8_WAIT_V(n) asm volatile("s_waitcnt vmcnt(" #n ")" ::: "memory")
#define PG8_WAIT_L(n) asm volatile("s_waitcnt lgkmcnt(" #n ")" ::: "memory")
#define PG8_BAR __builtin_amdgcn_s_barrier()
#define PG8_SCHED __builtin_amdgcn_sched_barrier(0)
    Unit cur, nxt; int ui = 0;
    if (!S.next(0, cur)) return;
    f32x4 acc[2][2][4][2];
#pragma unroll
    for (int a = 0; a < 2; ++a)
#pragma unroll
        for (int b = 0; b < 2; ++b)
#pragma unroll
            for (int m = 0; m < 4; ++m)
#pragma unroll
                for (int n = 0; n < 2; ++n) acc[a][b][m][n] = (f32x4){0.f, 0.f, 0.f, 0.f};
    bf16x8 At[4][2], B0[2][2], B1[2][2];
    const char* cA = (const char*)g.A + (size_t)cur.pm * tstep; const char* cB = (const char*)g.Bt + (size_t)cur.pn * tstep;
    S.a_ready(cur);
    if constexpr (SP2) {
        PG8_STAGE(PG8_SB(0, 0), cB, voffB); PG8_STAGE(PG8_SB(0, 1), cB + hstep, voffB); PG8_STAGE(PG8_SA(0, 0), cA, voffA); PG8_STAGE(PG8_SA(0, 1), cA + hstep, voffA);
        if (wr == 1) PG8_BAR;
        PG8_WAIT_V(2); PG8_BAR;
        PG8_STAGE(PG8_SB(1, 0), cB + kstep, voffB); PG8_STAGE(PG8_SA(1, 0), cA + kstep, voffA); PG8_STAGE(PG8_SB(1, 1), cB + hstep + kstep, voffB);
        PG8_WAIT_V(6); PG8_BAR;
    } else {
        PG8_STAGE(PG8_SB(0, 0), cB, voffB); PG8_STAGE(PG8_SA(0, 0), cA, voffA); PG8_STAGE(PG8_SB(0, 1), cB + hstep, voffB); PG8_STAGE(PG8_SA(0, 1), cA + hstep, voffA);
        if (wr == 1) PG8_BAR;
        PG8_WAIT_V(4); PG8_BAR;
        PG8_STAGE(PG8_SB(1, 0), cB + kstep, voffB); PG8_STAGE(PG8_SA(1, 0), cA + kstep, voffA); PG8_STAGE(PG8_SB(1, 1), cB + hstep + kstep, voffB);
        PG8_WAIT_V(6); PG8_BAR;
    }
    for (;;) {
        const bool has_next = S.next(ui + 1, nxt);
        const char* nA = has_next ? (const char*)g.A + (size_t)nxt.pm * tstep : cA; const char* nB = has_next ? (const char*)g.Bt + (size_t)nxt.pn * tstep : cB;
        for (int t = 0; t < nt; t += 2) {
            const bool last = (t == nt - 2);
            const char* a1 = cA + (size_t)(t + 1) * kstep;
            const char* a2 = last ? nA : cA + (size_t)(t + 2) * kstep; const char* b2 = last ? nB : cB + (size_t)(t + 2) * kstep;
            const char* a3 = a2 + kstep; const char* b3 = b2 + kstep;
            if (last && has_next) S.a_ready(nxt);
            if constexpr (SP2) {
            PG8_LDB(B0, 0, 0); PG8_LDB(B1, 0, 1); PG8_SCHED; PG8_LDA(At, 0, 0); PG8_STAGE(PG8_SA(1, 1), a1 + hstep, voffA);
            PG8_WAIT_V(8); PG8_WAIT_L(0); PG8_BAR; PG8_MMA(0, 0, At, B0); PG8_MMA(0, 1, At, B1); PG8_BAR; PG8_SCHED;
            PG8_LDA(At, 0, 1); PG8_STAGE(PG8_SB(0, 0), b2, voffB); PG8_STAGE(PG8_SB(0, 1), b2 + hstep, voffB); PG8_STAGE(PG8_SA(0, 0), a2, voffA);
            PG8_WAIT_V(8); PG8_WAIT_L(0); PG8_BAR; PG8_MMA(1, 0, At, B0); PG8_MMA(1, 1, At, B1); PG8_BAR; PG8_SCHED;
            PG8_LDB(B0, 1, 0); PG8_LDB(B1, 1, 1); PG8_SCHED; PG8_LDA(At, 1, 0); PG8_STAGE(PG8_SA(0, 1), a2 + hstep, voffA);
            PG8_WAIT_V(8); PG8_WAIT_L(0); PG8_BAR; PG8_MMA(0, 0, At, B0); PG8_MMA(0, 1, At, B1); PG8_BAR; PG8_SCHED;
            PG8_LDA(At, 1, 1); PG8_STAGE(PG8_SB(1, 0), b3, voffB); PG8_STAGE(PG8_SB(1, 1), b3 + hstep, voffB); PG8_STAGE(PG8_SA(1, 0), a3, voffA);
            PG8_WAIT_V(8); PG8_WAIT_L(0); PG8_BAR; PG8_MMA(1, 0, At, B0); PG8_MMA(1, 1, At, B1); PG8_BAR; PG8_SCHED;
            } else {
            PG8_LDB(B0, 0, 0); PG8_SCHED; PG8_LDA(At, 0, 0); PG8_STAGE(PG8_SA(1, 1), a1 + hstep, voffA);
            PG8_WAIT_L(8); PG8_BAR; PG8_WAIT_L(0); PG8_MMA(0, 0, At, B0); PG8_BAR; PG8_SCHED;
            PG8_LDB(B1, 0, 1); PG8_STAGE(PG8_SB(0, 0), b2, voffB);
            PG8_BAR; PG8_WAIT_L(0); PG8_MMA(0, 1, At, B1); PG8_BAR;
            PG8_LDA(At, 0, 1); PG8_STAGE(PG8_SA(0, 0), a2, voffA);
            PG8_BAR; PG8_WAIT_L(0); PG8_MMA(1, 0, At, B0); PG8_BAR; PG8_SCHED;
            PG8_STAGE(PG8_SB(0, 1), b2 + hstep, voffB);
            PG8_WAIT_V(6); PG8_BAR; PG8_MMA(1, 1, At, B1); PG8_BAR;
            PG8_LDB(B0, 1, 0); PG8_SCHED; PG8_LDA(At, 1, 0); PG8_STAGE(PG8_SA(0, 1), a2 + hstep, voffA);
            PG8_WAIT_L(8); PG8_BAR; PG8_WAIT_L(0); PG8_MMA(0, 0, At, B0); PG8_BAR; PG8_SCHED;
            PG8_LDB(B1, 1, 1); PG8_STAGE(PG8_SB(1, 0), b3, voffB);
            PG8_BAR; PG8_WAIT_L(0); PG8_MMA(0, 1, At, B1); PG8_BAR;
            PG8_LDA(At, 1, 1); PG8_STAGE(PG8_SA(1, 0), a3, voffA);
            PG8_BAR; PG8_WAIT_L(0); PG8_MMA(1, 0, At, B0); PG8_BAR; PG8_SCHED;
            PG8_STAGE(PG8_SB(1, 1), b3 + hstep, voffB);
            PG8_WAIT_V(6); PG8_BAR; PG8_MMA(1, 1, At, B1); PG8_BAR;
            }
        }
        if constexpr (ALIGN_EPI) { if (wr == 0) PG8_BAR; }
        if constexpr (!Epi::AFTER_DRAIN) { E(acc, cur, wr, wc, fr, fq); S.done(cur); }
        if (!has_next) break;
#pragma unroll
        for (int a = 0; a < 2; ++a)
#pragma unroll
            for (int b = 0; b < 2; ++b)
#pragma unroll
                for (int m = 0; m < 4; ++m)
#pragma unroll
                    for (int n = 0; n < 2; ++n) acc[a][b][m][n] = (f32x4){0.f, 0.f, 0.f, 0.f};
        cur = nxt; cA = nA; cB = nB; ++ui;
        if constexpr (ALIGN_EPI) { if (wr == 1) PG8_BAR; }
    }
    PG8_WAIT_V(0);
    if constexpr (!ALIGN_EPI) { if (wr == 0) PG8_BAR; }
    PG8_BAR;
    if constexpr (Epi::AFTER_DRAIN) { E.fused(acc, cur, wr, wc, fr, fq, lds, wid, lane); S.done(cur); }
#undef PG8_SA
#undef PG8_SB
#undef PG8_STAGE
#undef PG8_LDA
#undef PG8_LDB
#undef PG8_MMA
#undef PG8_WAIT_V
#undef PG8_WAIT_L
#undef PG8_BAR
#undef PG8_SCHED
}
}

#include <hip/hip_bf16.h>
#include <cmath>
namespace attn_body {
using bf16=__hip_bfloat16;
using bf16x8=__attribute__((ext_vector_type(8)))short;
using s16x4=__attribute__((ext_vector_type(4)))short;
using f32x16=__attribute__((ext_vector_type(16)))float;
using u32x4=__attribute__((ext_vector_type(4)))unsigned;
constexpr int D=64,PK=1536,PO=1024;
constexpr int NW=8,QBLK=32,QB=QBLK*NW,KVBLK=64;
constexpr int ATTN_UNIT_ROWS=QB;
__device__ __forceinline__ int crow(int r,int hi){return (r&3)+8*(r>>2)+4*hi;}
#define SBAR() __builtin_amdgcn_sched_barrier(0)
__device__ __forceinline__ void cmask(f32x16&p0,f32x16&p1,int jb,int qrel,int hi){
  const float NEG=-INFINITY; int kb=64*jb+4*hi;
  #pragma unroll
  for(int r=0;r<16;++r){int kv=kb+(r&3)+8*(r>>2); if(kv>qrel)p0[r]=NEG; if(kv+32>qrel)p1[r]=NEG;}
}

constexpr int NSLOT=3, SLOTB=8192;
constexpr int LDS_K=0, LDS_V=NSLOT*SLOTB, LDS_WS=2*NSLOT*SLOTB, LDS_OST=LDS_WS+NW*64*4, LDS_BYTES=LDS_OST+NW*4096;
constexpr float C2=0.125f*1.4426950408889634f;
__device__ __forceinline__ void glds16(const void*gsrc,unsigned lds_dst){unsigned keep;
  asm volatile("s_mov_b32 %0, m0\n\ts_mov_b32 m0, %2\n\ts_nop 0\n\tglobal_load_lds_dwordx4 %1, off\n\ts_mov_b32 m0, %0":"=&s"(keep):"v"(gsrc),"s"(lds_dst):"memory");}
__device__ __forceinline__ float max3f(float a,float b,float c){float r;asm("v_max3_f32 %0, %1, %2, %3":"=v"(r):"v"(a),"v"(b),"v"(c));return r;}
__device__ __forceinline__ float max2f(float a,float b){float r;asm("v_max_f32_e32 %0, %1, %2":"=v"(r):"v"(a),"v"(b));return r;}
__device__ __forceinline__ float fadd_s(float a,float b){float r;asm("v_add_f32_e32 %0, %1, %2":"=v"(r):"v"(a),"v"(b));return r;}
__device__ __forceinline__ float fsub_s(float a,float b){float r;asm("v_sub_f32_e32 %0, %1, %2":"=v"(r):"v"(a),"v"(b));return r;}
typedef float f32x2_t __attribute__((ext_vector_type(2))); typedef __bf16 bf16x2_t __attribute__((ext_vector_type(2)));
__device__ __forceinline__ unsigned cvtpk_s(float lo,float hi){f32x2_t v={lo,hi};bf16x2_t b=__builtin_convertvector(v,bf16x2_t);return __builtin_bit_cast(unsigned,b);}
#define WAIT_BAR(N) asm volatile("s_waitcnt vmcnt(" #N ") lgkmcnt(0)\n\ts_barrier":::"memory")

__device__ __forceinline__ void qkt(f32x16&p0,f32x16&p1,const char*Kslot,const bf16x8*qr,const f32x16&negm,int r32,int hi){
  const char*kb=Kslot+hi*1024+r32*16;
  #pragma unroll
  for(int d0=0;d0<4;++d0){
    const bf16x8 b0=*reinterpret_cast<const bf16x8*>(kb+d0*2048);
    const bf16x8 b1=*reinterpret_cast<const bf16x8*>(kb+d0*2048+512);
    if(d0==0){p0=__builtin_amdgcn_mfma_f32_32x32x16_bf16(b0,qr[0],negm,0,0,0);p1=__builtin_amdgcn_mfma_f32_32x32x16_bf16(b1,qr[0],negm,0,0,0);}
    else{p0=__builtin_amdgcn_mfma_f32_32x32x16_bf16(b0,qr[d0],p0,0,0,0);p1=__builtin_amdgcn_mfma_f32_32x32x16_bf16(b1,qr[d0],p1,0,0,0);}}
}
typedef __attribute__((address_space(3))) const char* lds_cptr;
typedef short v4i16_t __attribute__((ext_vector_type(4)));
__device__ __forceinline__ void kload8(bf16x8*kf,lds_cptr kp){
  kf[0]=*(const __attribute__((address_space(3))) bf16x8*)(kp);      kf[1]=*(const __attribute__((address_space(3))) bf16x8*)(kp+512);
  kf[2]=*(const __attribute__((address_space(3))) bf16x8*)(kp+2048); kf[3]=*(const __attribute__((address_space(3))) bf16x8*)(kp+2560);
  kf[4]=*(const __attribute__((address_space(3))) bf16x8*)(kp+4096); kf[5]=*(const __attribute__((address_space(3))) bf16x8*)(kp+4608);
  kf[6]=*(const __attribute__((address_space(3))) bf16x8*)(kp+6144); kf[7]=*(const __attribute__((address_space(3))) bf16x8*)(kp+6656);
}
__device__ __forceinline__ void kload2(bf16x8*kf,lds_cptr kp,int j){ kf[2*j]=*(const __attribute__((address_space(3))) bf16x8*)(kp+j*2048); kf[2*j+1]=*(const __attribute__((address_space(3))) bf16x8*)(kp+j*2048+512); }
__device__ __forceinline__ s16x4 vtr(lds_cptr p){ return __builtin_bit_cast(s16x4,__builtin_amdgcn_ds_read_tr16_b64_v4i16((__attribute__((address_space(3))) v4i16_t*)p)); }
__device__ __forceinline__ float rowmax(const f32x16&p0,const f32x16&p1){
  float a=max3f(p0[0],p0[1],p1[0]),b=max3f(p0[2],p0[3],p1[1]);a=max3f(a,p1[2],p1[3]);
  #pragma unroll
  for(int r=4;r<16;r+=4){a=max3f(a,p0[r],p0[r+1]);b=max3f(b,p0[r+2],p0[r+3]);a=max3f(a,p1[r],p1[r+1]);b=max3f(b,p1[r+2],p1[r+3]);}
  const float m=max2f(a,b);
  auto rr=__builtin_amdgcn_permlane32_swap(__float_as_uint(m),__float_as_uint(m),false,false);
  return max2f(__uint_as_float(rr[0]),__uint_as_float(rr[1]));
}
__device__ __forceinline__ void pv(f32x16*o,int vb,bf16x8 pa0,bf16x8 pa1,bf16x8 pa2,bf16x8 pa3){
  #pragma unroll
  for(int d0=0;d0<2;++d0){s16x4 lo[4],hi[4];
    #pragma unroll
    for(int ks=0;ks<4;++ks){
      asm volatile("ds_read_b64_tr_b16 %0,%1 offset:%c2":"=&v"(lo[ks]):"v"(vb),"i"(d0*4096+ks*1024):"memory");
      asm volatile("ds_read_b64_tr_b16 %0,%1 offset:%c2":"=&v"(hi[ks]):"v"(vb),"i"(d0*4096+ks*1024+512):"memory");}
    asm volatile("s_waitcnt lgkmcnt(0)":::"memory");SBAR();
    #define PK(k) (bf16x8){lo[k][0],lo[k][1],lo[k][2],lo[k][3],hi[k][0],hi[k][1],hi[k][2],hi[k][3]}
    o[d0]=__builtin_amdgcn_mfma_f32_32x32x16_bf16(pa0,PK(0),o[d0],0,0,0);
    o[d0]=__builtin_amdgcn_mfma_f32_32x32x16_bf16(pa1,PK(1),o[d0],0,0,0);
    o[d0]=__builtin_amdgcn_mfma_f32_32x32x16_bf16(pa2,PK(2),o[d0],0,0,0);
    o[d0]=__builtin_amdgcn_mfma_f32_32x32x16_bf16(pa3,PK(3),o[d0],0,0,0);
    #undef PK
  }
}

#ifndef ATTN_STORE16
#define ATTN_STORE16(p,v) (*(u32x4*)(p)=(v))
#endif
template<int THRL> __device__ __forceinline__ void attn_unit(const bf16*Qu,const bf16*__restrict__ Kh,const bf16*__restrict__ Vh,bf16*Ou,const int NT,char*shm,const float*qgain,const int t0){
  const int tid=pg8::opaque_tid(),lane=tid&63,r32=lane&31,hi=lane>>5; const int wid=__builtin_amdgcn_readfirstlane(tid>>6);
  const bf16*Qw=Qu+(long)(wid*QBLK)*PK;
  const unsigned lds0=(unsigned)(uintptr_t)shm;
  float*wsf=(float*)(shm+LDS_WS)+wid*64;
  const bf16*ksrc=Kh+(long)lane*PK+wid*8;
  const bf16*vsrc=Vh+(long)(16*(wid&3)+(lane>>2))*PK+(wid>>2)*32+(lane&3)*8;
  const unsigned kdst=lds0+LDS_K+wid*1024, vdst=lds0+LDS_V+wid*1024;
  #define DMA_K(t,slot) glds16(ksrc+(long)(t)*KVBLK*PK,(unsigned)__builtin_amdgcn_readfirstlane(kdst+(slot)))
  #define DMA_V(t,slot) glds16(vsrc+(long)(t)*KVBLK*PK,(unsigned)__builtin_amdgcn_readfirstlane(vdst+(slot)))
  const int vb0=(int)(lds0+LDS_V)+((lane>>4)&1)*32+(lane&3)*8+(4*hi+((lane&15)>>2))*64;
  const char*Kbase=shm+LDS_K; bf16x8 kf[8];
  const lds_cptr shm3=(lds_cptr)shm; const lds_cptr kp0=shm3+LDS_K+hi*1024+r32*16; const lds_cptr vp0=shm3+LDS_V+((lane>>4)&1)*32+(lane&3)*8+(4*hi+((lane&15)>>2))*64;
  DMA_K(0,0);DMA_V(0,0);DMA_K(1,SLOTB);
  bf16x8 qr[4];
  #pragma unroll
  for(int d0=0;d0<4;++d0)qr[d0]=*reinterpret_cast<const bf16x8*>(&Qw[(long)r32*PK+d0*16+hi*8]);
  {
    float qv[4][8];
    #pragma unroll
    for(int d0=0;d0<4;++d0){const u32x4 w=__builtin_bit_cast(u32x4,qr[d0]);
      qv[d0][0]=__uint_as_float(w.x<<16);qv[d0][1]=__uint_as_float(w.x&0xffff0000u);qv[d0][2]=__uint_as_float(w.y<<16);qv[d0][3]=__uint_as_float(w.y&0xffff0000u);
      qv[d0][4]=__uint_as_float(w.z<<16);qv[d0][5]=__uint_as_float(w.z&0xffff0000u);qv[d0][6]=__uint_as_float(w.w<<16);qv[d0][7]=__uint_as_float(w.w&0xffff0000u);}
    float ss=0.f;
    #pragma unroll
    for(int d0=0;d0<4;++d0){
      #pragma unroll
      for(int i=0;i<8;++i)ss+=qv[d0][i]*qv[d0][i];}
    {auto rr=__builtin_amdgcn_permlane32_swap(__float_as_uint(ss),__float_as_uint(ss),false,false);ss=__uint_as_float(rr[0])+__uint_as_float(rr[1]);}
    const float rstd=1.0f/sqrtf(ss*(1.0f/64.0f)+1e-6f);
    #pragma unroll
    for(int d0=0;d0<4;++d0){
      #pragma unroll
      for(int i=0;i<8;++i)qv[d0][i]=qv[d0][i]*rstd*qgain[d0*16+hi*8+i];}
    if(t0>=0){const int tq=t0+wid*QBLK+r32;const float rp=(float)(tq>>6),cp=(float)(tq&63);
      #pragma unroll
      for(int i=0;i<8;++i){const float inv=exp2f(-(float)(hi*8+i)*(13.287712379549449f/16.0f));
        {const float a=rp*inv,c=__cosf(a),s=__sinf(a),x1=qv[0][i],x2=qv[1][i];qv[0][i]=x1*c-x2*s;qv[1][i]=x2*c+x1*s;}
        {const float a=cp*inv,c=__cosf(a),s=__sinf(a),x1=qv[2][i],x2=qv[3][i];qv[2][i]=x1*c-x2*s;qv[3][i]=x2*c+x1*s;}}}
    #pragma unroll
    for(int d0=0;d0<4;++d0){u32x4 w;w.x=cvtpk_s(qv[d0][0]*C2,qv[d0][1]*C2);w.y=cvtpk_s(qv[d0][2]*C2,qv[d0][3]*C2);w.z=cvtpk_s(qv[d0][4]*C2,qv[d0][5]*C2);w.w=cvtpk_s(qv[d0][6]*C2,qv[d0][7]*C2);qr[d0]=__builtin_bit_cast(bf16x8,w);}
  }
  float mhat=0.f,l_reg=0.f;f32x16 o[2];o[0]=f32x16{};o[1]=f32x16{};f32x16 negm=f32x16{};asm volatile("":"+v"(negm));
  #define CMASK(P0,P1,t) do{}while(0)
  bool resc=false;
  #define START(P0,P1) do{ const float rm=rowmax(P0,P1); resc=false; \
    { const float dl=rm; mhat=fadd_s(mhat,dl); \
      _Pragma("unroll") for(int r=0;r<16;++r){P0[r]=fsub_s(P0[r],dl);P1[r]=fsub_s(P1[r],dl);} \
      _Pragma("unroll") for(int r=0;r<16;++r)negm[r]=-mhat; asm volatile("":"+v"(negm)); } \
    _Pragma("unroll") for(int r=0;r<16;++r)P0[r]=__builtin_amdgcn_exp2f(P0[r]); }while(0)
  #define RESC() do{ if(resc){ asm volatile("s_waitcnt lgkmcnt(0)":::"memory"); \
      _Pragma("unroll") for(int d_=0;d_<2;++d_) _Pragma("unroll") for(int r=0;r<16;++r)o[d_][r]*=wsf[crow(r,hi)]; } }while(0)
  f32x16 pA0,pA1,pB0,pB1;
  int sl_prev=0,sl_cur=0,sl_next=SLOTB;
  #define ROT() do{sl_prev=sl_cur;sl_cur=sl_next;sl_next=(sl_next==(NSLOT-1)*SLOTB)?0:sl_next+SLOTB;}while(0)
  DMA_K(2,2*SLOTB);
  WAIT_BAR(3);
  qkt(pA0,pA1,Kbase,qr,negm,r32,hi);asm volatile("s_nop 15\n\ts_nop 7":"+v"(pA0),"+v"(pA1));CMASK(pA0,pA1,0);
  START(pA0,pA1);
  _Pragma("unroll") for(int r=0;r<16;++r)pA1[r]=__builtin_amdgcn_exp2f(pA1[r]);
  WAIT_BAR(0);
  DMA_K(3,0);DMA_V(1,SLOTB);
  ROT();
  kload8(kf,kp0+sl_cur);
  WAIT_BAR(2);
  s16x4 vlo[8],vhi[8]; u32x4 pw0,pw1,pw2,pw3;
  #define PKW(P,B) cvtpk_s(P[B],P[B+1])
  #define PAF(k) __builtin_bit_cast(bf16x8,pw##k)
  #define VFR(i) (bf16x8){vlo[i][0],vlo[i][1],vlo[i][2],vlo[i][3],vhi[i][0],vhi[i][1],vhi[i][2],vhi[i][3]}
  #define PIN(x) asm volatile("":"+v"(x))
  #define MX3(a,b,c) __builtin_fmaxf(__builtin_fmaxf((a),(b)),(c))
  #define GAPA(MF,A0,A1,A2,A3,W0,W1,PW) do{ MF; sacc+=A0; sacc+=A1; sacc+=A2; sacc+=A3; PIN(sacc); W0; W1; PIN(PW); SBAR(); }while(0)
  #define EX(v) __builtin_amdgcn_exp2f(v)
  #define GAPB(MF,X,B) do{ MF; X[B]=EX(X[B]); X[B+1]=EX(X[B+1]); X[B+2]=EX(X[B+2]); X[B+3]=EX(X[B+3]); PIN(X); SBAR(); }while(0)
  #define VRD(i) do{ vlo[i]=vtr(vp_+(((i)>>2)*4096+((i)&3)*1024)); vhi[i]=vtr(vp_+(((i)>>2)*4096+((i)&3)*1024+512)); }while(0)
  #define KRD(G,j) do{ if(G){ kload2(kf,kp0+sl_next,j); SBAR(); } }while(0)
  #define STEP(C0,C1,P0,P1,t,GK,GV,GL) do{ SBAR(); \
    const lds_cptr vp_=vp0+sl_prev; \
    VRD(0); SBAR(); float sacc=(P0[0]+P0[1]); \
    GAPA(C0=__builtin_amdgcn_mfma_f32_32x32x16_bf16(kf[0],qr[0],negm,0,0,0), P0[2],P0[3],P0[4],P0[5],     pw0[0]=PKW(P0,0), pw0[1]=PKW(P0,2), pw0); \
    VRD(4); SBAR(); GAPA(C1=__builtin_amdgcn_mfma_f32_32x32x16_bf16(kf[1],qr[0],negm,0,0,0), P0[6],P0[7],P0[8],P0[9],     pw0[2]=PKW(P0,4), pw0[3]=PKW(P0,6), pw0); \
    VRD(1); SBAR(); GAPA(C0=__builtin_amdgcn_mfma_f32_32x32x16_bf16(kf[2],qr[1],C0,0,0,0),   P0[10],P0[11],P0[12],P0[13], pw1[0]=PKW(P0,8), pw1[1]=PKW(P0,10), pw1); \
    VRD(5); SBAR(); GAPA(C1=__builtin_amdgcn_mfma_f32_32x32x16_bf16(kf[3],qr[1],C1,0,0,0),   P0[14],P0[15],P1[0],P1[1],   pw1[2]=PKW(P0,12),pw1[3]=PKW(P0,14), pw1); \
    VRD(2); SBAR(); GAPA(C0=__builtin_amdgcn_mfma_f32_32x32x16_bf16(kf[4],qr[2],C0,0,0,0),   P1[2],P1[3],P1[4],P1[5],     pw2[0]=PKW(P1,0), pw2[1]=PKW(P1,2), pw2); \
    VRD(6); SBAR(); GAPA(C1=__builtin_amdgcn_mfma_f32_32x32x16_bf16(kf[5],qr[2],C1,0,0,0),   P1[6],P1[7],P1[8],P1[9],     pw2[2]=PKW(P1,4), pw2[3]=PKW(P1,6), pw2); \
    VRD(3); SBAR(); GAPA(C0=__builtin_amdgcn_mfma_f32_32x32x16_bf16(kf[6],qr[3],C0,0,0,0),   P1[10],P1[11],P1[12],P1[13], pw3[0]=PKW(P1,8), pw3[1]=PKW(P1,10), pw3); \
    VRD(7); SBAR(); GAPA(C1=__builtin_amdgcn_mfma_f32_32x32x16_bf16(kf[7],qr[3],C1,0,0,0),   P1[14],P1[15],0.f,0.f,       pw3[2]=PKW(P1,12),pw3[3]=PKW(P1,14), pw3); \
    l_reg+=sacc; \
    if(GK){DMA_K((t)+3,sl_cur);} if(GV){DMA_V((t)+1,sl_next);} \
    CMASK(C0,C1,t); \
    { float a=MX3(C0[0],C0[1],C1[0]),b=MX3(C0[2],C0[3],C1[1]); a=MX3(a,C1[2],C1[3]); \
      _Pragma("unroll") for(int r=4;r<16;r+=4){a=MX3(a,C0[r],C0[r+1]);b=MX3(b,C0[r+2],C0[r+3]);a=MX3(a,C1[r],C1[r+1]);b=MX3(b,C1[r+2],C1[r+3]);} \
      float rm=__builtin_fmaxf(a,b); { auto rr=__builtin_amdgcn_permlane32_swap(__float_as_uint(rm),__float_as_uint(rm),false,false); rm=__builtin_fmaxf(__uint_as_float(rr[0]),__uint_as_float(rr[1])); } \
      resc=false; \
      if(__builtin_expect(__any(rm>(float)THRL),0)){ const float dl=__builtin_fmaxf(rm,0.f); mhat+=dl; \
        _Pragma("unroll") for(int r=0;r<16;++r){C0[r]-=dl;C1[r]-=dl;} \
        _Pragma("unroll") for(int r=0;r<16;++r)negm[r]=-mhat; asm volatile("":"+v"(negm)); \
        const float f=__builtin_amdgcn_exp2f(-dl); l_reg*=f; if(hi==0)wsf[r32]=f; resc=true; } } \
    SBAR(); \
    GAPB(o[0]=__builtin_amdgcn_mfma_f32_32x32x16_bf16(PAF(0),VFR(0),o[0],0,0,0), C0,0); \
    GAPB(o[1]=__builtin_amdgcn_mfma_f32_32x32x16_bf16(PAF(0),VFR(4),o[1],0,0,0), C0,4); \
    KRD(GL,0); GAPB(o[0]=__builtin_amdgcn_mfma_f32_32x32x16_bf16(PAF(1),VFR(1),o[0],0,0,0), C0,8); \
    KRD(GL,1); GAPB(o[1]=__builtin_amdgcn_mfma_f32_32x32x16_bf16(PAF(1),VFR(5),o[1],0,0,0), C0,12); \
    KRD(GL,2); GAPB(o[0]=__builtin_amdgcn_mfma_f32_32x32x16_bf16(PAF(2),VFR(2),o[0],0,0,0), C1,0); \
    KRD(GL,3); GAPB(o[1]=__builtin_amdgcn_mfma_f32_32x32x16_bf16(PAF(2),VFR(6),o[1],0,0,0), C1,4); \
    GAPB(o[0]=__builtin_amdgcn_mfma_f32_32x32x16_bf16(PAF(3),VFR(3),o[0],0,0,0), C1,8); \
    GAPB(o[1]=__builtin_amdgcn_mfma_f32_32x32x16_bf16(PAF(3),VFR(7),o[1],0,0,0), C1,12); \
    }while(0)
  int t=1;
  for(;t+5<NT;t+=2){
    STEP(pB0,pB1,pA0,pA1,t,true,true,true);     WAIT_BAR(2); RESC(); ROT();
    STEP(pA0,pA1,pB0,pB1,t+1,true,true,true);   WAIT_BAR(2); RESC(); ROT();
  }
  #define ENDW(tt) do{ if((tt)+3<NT){WAIT_BAR(2);} else if((tt)+2<NT){WAIT_BAR(1);} else {WAIT_BAR(0);} }while(0)
  for(;t+1<NT;t+=2){
    STEP(pB0,pB1,pA0,pA1,t,(t+3<NT),(t+1<NT),(t+1<NT));       ENDW(t);   RESC(); ROT();
    STEP(pA0,pA1,pB0,pB1,t+1,(t+4<NT),(t+2<NT),(t+2<NT));     ENDW(t+1); RESC(); ROT();
  }
  STEP(pB0,pB1,pA0,pA1,NT-1,false,false,false); RESC();
  { float sacc=pB0[0]+pB0[1]; _Pragma("unroll") for(int r=2;r<16;++r)sacc+=pB0[r]; _Pragma("unroll") for(int r=0;r<16;++r)sacc+=pB1[r]; l_reg+=sacc;
    pw0=(u32x4){PKW(pB0,0),PKW(pB0,2),PKW(pB0,4),PKW(pB0,6)};pw1=(u32x4){PKW(pB0,8),PKW(pB0,10),PKW(pB0,12),PKW(pB0,14)};pw2=(u32x4){PKW(pB1,0),PKW(pB1,2),PKW(pB1,4),PKW(pB1,6)};pw3=(u32x4){PKW(pB1,8),PKW(pB1,10),PKW(pB1,12),PKW(pB1,14)};
    SBAR(); pv(o,vb0+sl_cur,PAF(0),PAF(1),PAF(2),PAF(3)); }
  #undef PKW
  #undef PAF
  #undef VFR
  #undef PIN
  #undef MX3
  #undef GAPA
  #undef GAPB
  #undef EX
  #undef VRD
  #undef KRD
  #undef STEP
  #undef ENDW
  {auto rr=__builtin_amdgcn_permlane32_swap(__float_as_uint(l_reg),__float_as_uint(l_reg),false,false);l_reg=__uint_as_float(rr[0])+__uint_as_float(rr[1]);}
  if(hi==0)wsf[32+r32]=l_reg;asm volatile("s_waitcnt lgkmcnt(0)":::"memory");
  float rli[16];
  #pragma unroll
  for(int r=0;r<16;++r)rli[r]=__builtin_amdgcn_rcpf(wsf[32+crow(r,hi)]);
  bf16*Ow=Ou+(long)(wid*QBLK)*PO;
  { bf16*stg=(bf16*)(shm+LDS_OST)+wid*2048;
    #pragma unroll
    for(int r=0;r<16;++r){const int orow=crow(r,hi);
      #pragma unroll
      for(int d0=0;d0<2;++d0)stg[orow*64+d0*32+r32]=__float2bfloat16(o[d0][r]*rli[r]);}
    asm volatile("s_waitcnt lgkmcnt(0)":::"memory");
    #pragma unroll
    for(int i=0;i<4;++i){const int row=i*8+(lane>>3),ch=lane&7; const u32x4 v=*(const u32x4*)(stg+row*64+ch*8); ATTN_STORE16(Ow+(long)row*PO+ch*8,v);} }
  asm volatile("s_waitcnt lgkmcnt(0)\n\ts_barrier":::"memory");
  #undef DMA_K
  #undef DMA_V
  #undef CMASK
  #undef START
  #undef RESC
  #undef ROT
}
constexpr int ATTN_LDS_BYTES=LDS_BYTES;
#undef SBAR
#undef WAIT_BAR
}
constexpr int NB = 32, SEQ = 2048, CTXL = 256, TPB = SEQ + CTXL, MTOK = NB * TPB, DM = 1024, INW = 1536, FF = 2816, FF2 = 5632, MODW = 6144, NLAYER = 2;
constexpr int NTILE = MTOK / 256;
constexpr float EPS = 1e-6f;
constexpr size_t MiB = 1u << 20;
constexpr size_t WS_BAR = 0;
constexpr size_t WS_MOD = 1 * MiB;
constexpr size_t WS_WSB = 3 * MiB;
constexpr size_t WS_WPT = 3 * MiB + 512 * 1024;
constexpr size_t WS_PRM = 3 * MiB + 768 * 1024;
constexpr int PRM_N1G = 0, PRM_N2G = 1024, PRM_QG = 2048, PRM_KG = 2112, PRM_BS = 2176, PRM_PSC = 2688, PRM_CW = 2944, PRM_CB = PRM_CW + 3 * 5632, PRM_L = PRM_CB + 5632;
constexpr size_t WS_WIN = 4 * MiB, WS_WOUT = 10 * MiB, WS_WUP = 14 * MiB, WS_WDN = 36 * MiB;
constexpr size_t WS_SB = 48 * MiB;
constexpr size_t WS_X = 148 * MiB;
constexpr size_t WS_H = 436 * MiB;
constexpr size_t WS_P = 580 * MiB;
constexpr size_t WS_MIX = 796 * MiB;
constexpr size_t WS_A = 580 * MiB;
constexpr size_t WS_END = 976 * MiB;
static_assert(WS_SB + (size_t)NTILE * 8 * 4 * 2816 * 4 <= WS_X && WS_X + (size_t)MTOK * 1024 * 4 <= WS_H && WS_H + (size_t)MTOK * 1024 * 2 <= WS_P && WS_P + (size_t)MTOK * 1536 * 2 <= WS_MIX && WS_MIX + (size_t)MTOK * 1024 * 2 <= WS_END && WS_A + (size_t)MTOK * 2816 * 2 <= WS_END, "d_ws map");
static_assert(WS_WDN + 2 * (size_t)1024 * 2816 * 2 <= WS_SB && WS_WUP + 2 * (size_t)5632 * 1024 * 2 <= WS_WDN && WS_WOUT + 2 * (size_t)1024 * 1024 * 2 <= WS_WUP && WS_WIN + 2 * (size_t)1536 * 1024 * 2 <= WS_WOUT, "weights map");
constexpr int LDS_BYTES = 147456;

#define LAS __attribute__((address_space(3)))
typedef unsigned short bf16;
typedef unsigned v4u __attribute__((ext_vector_type(4)));
typedef unsigned v2u __attribute__((ext_vector_type(2)));
typedef float f32x4 __attribute__((ext_vector_type(4)));
typedef short bf16x8 __attribute__((ext_vector_type(8)));
#define LDS_WAIT() asm volatile("s_waitcnt lgkmcnt(0)" ::: "memory")
__device__ __forceinline__ unsigned pk2(float lo, float hi) { return pg8::cvtpk2(lo, hi); }
__device__ __forceinline__ float bflo(unsigned u) { return __uint_as_float(u << 16); }
__device__ __forceinline__ float bfhi(unsigned u) { return __uint_as_float(u & 0xffff0000u); }
__device__ __forceinline__ float wave_sum(float v) {
#pragma unroll
    for (int o = 1; o < 64; o <<= 1) v += __shfl_xor(v, o);
    return v;
}

__device__ __forceinline__ void p0_transpose_item(const float* W, int K, int N, bf16* WT, bool upperm, LAS float* scr, int item, int lane) {
    const int nblk = N / 32, kb = item / nblk, nb = item % nblk, k0 = 64 * kb, n0 = 32 * nb;
#pragma unroll 8
    for (int i = 0; i < 32; ++i) { const int kk = 2 * i + (lane >> 5); scr[kk * 33 + (lane & 31)] = W[(size_t)(k0 + kk) * N + n0 + (lane & 31)]; }
    LDS_WAIT(); asm volatile("" ::: "memory");
    int r0 = n0;
    if (upperm) { const int j = (n0 < FF) ? n0 : n0 - FF; r0 = 256 * (j >> 7) + (j & 127) + ((n0 < FF) ? 0 : 128); }
    const int c = lane & 7;
#pragma unroll
    for (int j = 0; j < 4; ++j) { const int n = (lane >> 3) + 8 * j; const LAS float* s = scr + (8 * c) * 33 + n;
        v4u o; o.x = pk2(s[0 * 33], s[1 * 33]); o.y = pk2(s[2 * 33], s[3 * 33]); o.z = pk2(s[4 * 33], s[5 * 33]); o.w = pk2(s[6 * 33], s[7 * 33]);
        *(v4u*)(WT + (size_t)(r0 + n) * K + k0 + 8 * c) = o; }
    LDS_WAIT(); asm volatile("" ::: "memory");
}

#define XB_TMO      128
#define XB_XCNT(j)  (256  + 64 * (j))
#define XB_XSUB(j)  (1280 + 64 * (j))
#define XB_XGEN(j)  (2304 + 64 * (j))
#define XB_TOP      3328
#define XB_TOPGEN   3392
#define XCD_BAR_WORDS 3456
#define XB_SPIN_CAP (1u << 18)

__device__ __forceinline__ unsigned xb_ld(unsigned* p)              { return __hip_atomic_load(p, __ATOMIC_RELAXED, __HIP_MEMORY_SCOPE_AGENT); }
__device__ __forceinline__ unsigned xb_add(unsigned* p, unsigned v) { return __hip_atomic_fetch_add(p, v, __ATOMIC_RELAXED, __HIP_MEMORY_SCOPE_AGENT); }
__device__ __forceinline__ unsigned xb_xcc_id() { return (unsigned)__builtin_amdgcn_s_getreg((3 << 11) | 20) & 0xFu; }
#define XB_SPIN(cond, bar) do { unsigned _sp = 0; while (cond) { __builtin_amdgcn_s_sleep(1); \
    if ((++_sp & 255u) == 0u) { if (xb_ld(&(bar)[XB_TMO])) break; if (_sp > XB_SPIN_CAP) { atomicAdd(&(bar)[XB_TMO], 1u); break; } } } } while (0)

struct XcdBarrier {
    unsigned* bar; unsigned x;
    volatile LAS unsigned* st;
};

__device__ __forceinline__ XcdBarrier xcd_barrier_post(unsigned* bar, volatile LAS unsigned* st) {
    XcdBarrier b; b.bar = bar; b.x = xb_xcc_id(); b.st = st;
    if (threadIdx.x == 0) (void)xb_add(&bar[XB_XCNT(b.x)], 1u);
    return b;
}
__device__ __forceinline__ void xcd_barrier_complete(unsigned* bar, unsigned x, unsigned& nloc, unsigned& nx) {
    const unsigned G = gridDim.x * gridDim.y * gridDim.z;
    unsigned sum, cnt, mine, sp = 0u;
    for (;;) {
        sum = 0u; cnt = 0u; mine = 0u;
#pragma unroll
        for (unsigned j = 0; j < 16; ++j) { const unsigned c = xb_ld(&bar[XB_XCNT(j)]); sum += c; cnt += (c > 0u) ? 1u : 0u; mine = (j == x) ? c : mine; }
        if (sum == G) break;
        __builtin_amdgcn_s_sleep(1);
        if ((++sp & 255u) == 0u) { if (xb_ld(&bar[XB_TMO])) break; if (sp > XB_SPIN_CAP) { atomicAdd(&bar[XB_TMO], 1u); break; } }
    }
    nloc = mine > 0u ? mine : 1u; nx = cnt > 0u ? cnt : 1u;
}

__device__ __forceinline__ void xcd_barrier(const XcdBarrier& b) {
    asm volatile("s_waitcnt vmcnt(0)" ::: "memory");
    __syncthreads();
    if (threadIdx.x == 0) {
        unsigned* bar = b.bar;
        __builtin_amdgcn_s_waitcnt(0);
        unsigned nloc = b.st[0], nx = b.st[1];
        if (nloc == 0u) { xcd_barrier_complete(bar, b.x, nloc, nx); b.st[0] = nloc; b.st[1] = nx; }
        const unsigned old = xb_add(&bar[XB_XSUB(b.x)], 1u);
        const unsigned gen = old / nloc;
        if (old + 1u == (gen + 1u) * nloc) {
            __builtin_amdgcn_fence(__ATOMIC_RELEASE, "agent");
            asm volatile("s_waitcnt vmcnt(0)" ::: "memory");
            const unsigned og = xb_add(&bar[XB_TOP], 1u);
            const unsigned tg = og / nx;
            if (og + 1u == (tg + 1u) * nx) xb_add(&bar[XB_TOPGEN], 1u);
            else XB_SPIN(xb_ld(&bar[XB_TOPGEN]) == tg, bar);
            __builtin_amdgcn_fence(__ATOMIC_ACQUIRE, "agent");
            xb_add(&bar[XB_XGEN(b.x)], 1u);
            asm volatile("s_waitcnt vmcnt(0)" ::: "memory");
        } else {
            XB_SPIN(xb_ld(&bar[XB_XGEN(b.x)]) == gen, bar);
            __builtin_amdgcn_fence(__ATOMIC_ACQUIRE, "agent");
            asm volatile("s_waitcnt vmcnt(0)" ::: "memory");
        }
    }
    __syncthreads();
}

struct Args { const float* in[21]; float* out; unsigned char* ws; };

__device__ __forceinline__ void mod_phase(const Args& a, LAS unsigned char* lds, int tid) {
    LAS float* S = (LAS float*)lds;
    LAS float* OUT = (LAS float*)(lds + 33 * 1024 * 4);
    const float* c = a.in[1]; const float* cc = a.in[3]; const float* wmod = a.in[4]; const float* bmod = a.in[5];
    float* MOD = (float*)(a.ws + WS_MOD);
#pragma unroll 11
    for (int i = tid; i < 33 * 1024; i += 512) { const int m = i >> 10, k = i & 1023; const float v = (m < 32) ? c[m * 1024 + k] : cc[k]; S[i] = v / (1.0f + __expf(-v)); }
    __syncthreads();
    for (int u = blockIdx.x; u < 384; u += gridDim.x) {
        const int l = u / 192, col0 = (u % 192) * 32;
        for (int i = tid; i < 33 * 32; i += 512) OUT[i] = 0.f;
        __syncthreads();
        const int col = tid & 31, kc = tid >> 5;
        float acc[33];
#pragma unroll
        for (int m = 0; m < 33; ++m) acc[m] = 0.f;
        const float* W = wmod + (size_t)l * 1024 * MODW + col0 + col;
        for (int k4 = 0; k4 < 16; ++k4) {
            const int k = kc * 64 + k4 * 4;
            const float w0 = W[(size_t)(k + 0) * MODW], w1 = W[(size_t)(k + 1) * MODW], w2 = W[(size_t)(k + 2) * MODW], w3 = W[(size_t)(k + 3) * MODW];
#pragma unroll
            for (int m = 0; m < 33; ++m) { const f32x4 s = *(const LAS f32x4*)(S + m * 1024 + k); acc[m] += (s[0] * w0 + s[1] * w1) + (s[2] * w2 + s[3] * w3); }
        }
#pragma unroll
        for (int m = 0; m < 33; ++m) acc[m] += __shfl_xor(acc[m], 32);
        for (int w = 0; w < 8; ++w) {
            if ((tid >> 6) == w && (tid & 63) < 32) {
#pragma unroll
                for (int m = 0; m < 33; ++m) OUT[m * 32 + col] += acc[m];
            }
            __syncthreads();
        }
        for (int i = tid; i < 33 * 32; i += 512) { const int m = i >> 5, q = i & 31; MOD[(size_t)(l * 33 + m) * MODW + col0 + q] = OUT[i] + bmod[l * MODW + col0 + q]; }
        __syncthreads();
    }
}

__device__ __forceinline__ void norm_phase(const float* xin, const float* ctxin, const float* Xb, int from_inputs, const float* gvec, const float* mod, int sh_off, int sc_off,
                                           bf16* H, int skip_ctx, int gw, int NGW, int lane) {
    const int rpw = (((MTOK + NGW - 1) / NGW) + 1) & ~1; const int r0 = gw * rpw; int r1 = r0 + rpw; if (r1 > MTOK) r1 = MTOK;
    int cur = -1; f32x4 gs[4], shv[4];
#pragma unroll
    for (int j = 0; j < 4; ++j) { gs[j] = (f32x4){0.f, 0.f, 0.f, 0.f}; shv[j] = gs[j]; }
    for (int r = r0; r < r1; r += 2) {
        const int b = r / TPB, t = r - b * TPB; const int midx = (t >= SEQ) ? 32 : b;
        if (skip_ctx && t >= SEQ) continue;
        if (midx != cur) { cur = midx;
#pragma unroll
            for (int j = 0; j < 4; ++j) { const int cidx = 4 * lane + 256 * j; const f32x4 g = *(const f32x4*)(gvec + cidx), sc = *(const f32x4*)(mod + (size_t)midx * MODW + sc_off + cidx);
                gs[j] = g * (sc + 1.0f); shv[j] = *(const f32x4*)(mod + (size_t)midx * MODW + sh_off + cidx); } }
        const float* xr = from_inputs ? (t < SEQ ? xin + ((size_t)b * SEQ + t) * DM : ctxin + ((size_t)b * CTXL + (t - SEQ)) * DM) : Xb + (size_t)r * DM;
        f32x4 v[2][4]; float ss0 = 0.f, ss1 = 0.f;
#pragma unroll
        for (int j = 0; j < 4; ++j) { v[0][j] = *(const f32x4*)(xr + 4 * lane + 256 * j); v[1][j] = *(const f32x4*)(xr + DM + 4 * lane + 256 * j); }
#pragma unroll
        for (int j = 0; j < 4; ++j) { ss0 += (v[0][j][0] * v[0][j][0] + v[0][j][1] * v[0][j][1]) + (v[0][j][2] * v[0][j][2] + v[0][j][3] * v[0][j][3]);
                                      ss1 += (v[1][j][0] * v[1][j][0] + v[1][j][1] * v[1][j][1]) + (v[1][j][2] * v[1][j][2] + v[1][j][3] * v[1][j][3]); }
#pragma unroll
        for (int o = 1; o < 64; o <<= 1) { ss0 += __shfl_xor(ss0, o); ss1 += __shfl_xor(ss1, o); }
        const float rstd0 = 1.0f / sqrtf(ss0 * (1.0f / DM) + EPS), rstd1 = 1.0f / sqrtf(ss1 * (1.0f / DM) + EPS);
        bf16* hr = H + (size_t)r * DM;
#pragma unroll
        for (int j = 0; j < 4; ++j) { const f32x4 o0 = v[0][j] * rstd0 * gs[j] + shv[j], o1 = v[1][j] * rstd1 * gs[j] + shv[j];
            v2u w0; w0.x = pk2(o0[0], o0[1]); w0.y = pk2(o0[2], o0[3]); *(v2u*)(hr + 4 * lane + 256 * j) = w0;
            v2u w1; w1.x = pk2(o1[0], o1[1]); w1.y = pk2(o1[2], o1[3]); *(v2u*)(hr + DM + 4 * lane + 256 * j) = w1; }
    }
}
__device__ __forceinline__ void unpack8(v4u r, f32x4& a, f32x4& b) { a = (f32x4){bflo(r.x), bfhi(r.x), bflo(r.y), bfhi(r.y)}; b = (f32x4){bflo(r.z), bfhi(r.z), bflo(r.w), bfhi(r.w)}; }
__device__ __forceinline__ float sq8(const f32x4& a, const f32x4& b) { return ((a[0] * a[0] + a[1] * a[1]) + (a[2] * a[2] + a[3] * a[3])) + ((b[0] * b[0] + b[1] * b[1]) + (b[2] * b[2] + b[3] * b[3])); }
__device__ __forceinline__ void norm_phase_b(const bf16* Xb, const float* gvec, const float* mod, int sh_off, int sc_off, bf16* H, int skip_ctx, int gw, int NGW, int lane) {
    const int rpw = (((MTOK + NGW - 1) / NGW) + 1) & ~1; const int r0 = gw * rpw; int r1 = r0 + rpw; if (r1 > MTOK) r1 = MTOK;
    int cur = -1; f32x4 gs[2][2], shv[2][2];
#pragma unroll
    for (int j = 0; j < 2; ++j) { gs[j][0] = (f32x4){0.f, 0.f, 0.f, 0.f}; gs[j][1] = gs[j][0]; shv[j][0] = gs[j][0]; shv[j][1] = gs[j][0]; }
    for (int r = r0; r < r1; r += 2) {
        const int b = r / TPB, t = r - b * TPB; const int midx = (t >= SEQ) ? 32 : b;
        if (skip_ctx && t >= SEQ) continue;
        if (midx != cur) { cur = midx;
#pragma unroll
            for (int j = 0; j < 2; ++j)
#pragma unroll
                for (int q = 0; q < 2; ++q) { const int cidx = 8 * lane + 512 * j + 4 * q; const f32x4 g = *(const f32x4*)(gvec + cidx), sc = *(const f32x4*)(mod + (size_t)midx * MODW + sc_off + cidx);
                    gs[j][q] = g * (sc + 1.0f); shv[j][q] = *(const f32x4*)(mod + (size_t)midx * MODW + sh_off + cidx); } }
        const bf16* xr = Xb + (size_t)r * DM + 8 * lane;
        const v4u ra0 = *(const v4u*)(xr), ra1 = *(const v4u*)(xr + 512), rb0 = *(const v4u*)(xr + DM), rb1 = *(const v4u*)(xr + DM + 512);
        f32x4 a[2][2], c[2][2];
        unpack8(ra0, a[0][0], a[0][1]); unpack8(ra1, a[1][0], a[1][1]); unpack8(rb0, c[0][0], c[0][1]); unpack8(rb1, c[1][0], c[1][1]);
        float ss0 = sq8(a[0][0], a[0][1]) + sq8(a[1][0], a[1][1]), ss1 = sq8(c[0][0], c[0][1]) + sq8(c[1][0], c[1][1]);
#pragma unroll
        for (int o = 1; o < 64; o <<= 1) { ss0 += __shfl_xor(ss0, o); ss1 += __shfl_xor(ss1, o); }
        const float rstd0 = 1.0f / sqrtf(ss0 * (1.0f / DM) + EPS), rstd1 = 1.0f / sqrtf(ss1 * (1.0f / DM) + EPS);
        bf16* hr = H + (size_t)r * DM + 8 * lane;
#pragma unroll
        for (int j = 0; j < 2; ++j) {
            const f32x4 p0 = a[j][0] * rstd0 * gs[j][0] + shv[j][0], p1 = a[j][1] * rstd0 * gs[j][1] + shv[j][1];
            const f32x4 q0 = c[j][0] * rstd1 * gs[j][0] + shv[j][0], q1 = c[j][1] * rstd1 * gs[j][1] + shv[j][1];
            v4u w0; w0.x = pk2(p0[0], p0[1]); w0.y = pk2(p0[2], p0[3]); w0.z = pk2(p1[0], p1[1]); w0.w = pk2(p1[2], p1[3]); *(v4u*)(hr + 512 * j) = w0;
            v4u w1; w1.x = pk2(q0[0], q0[1]); w1.y = pk2(q0[2], q0[3]); w1.z = pk2(q1[0], q1[1]); w1.w = pk2(q1[2], q1[3]); *(v4u*)(hr + DM + 512 * j) = w1; }
    }
}
__device__ __forceinline__ void final_norm_phase(const bf16* Xb, const float* gvec, float* out, int gw, int NGW, int lane) {
    f32x4 g[2][2];
#pragma unroll
    for (int j = 0; j < 2; ++j)
#pragma unroll
        for (int q = 0; q < 2; ++q) g[j][q] = *(const f32x4*)(gvec + 8 * lane + 512 * j + 4 * q);
    for (int i = gw * 2; i < NB * SEQ; i += NGW * 2) {
        const int b = i / SEQ, t = i - b * SEQ; const bf16* xr = Xb + ((size_t)b * TPB + t) * DM + 8 * lane;
        const v4u ra0 = *(const v4u*)(xr), ra1 = *(const v4u*)(xr + 512), rb0 = *(const v4u*)(xr + DM), rb1 = *(const v4u*)(xr + DM + 512);
        f32x4 a[2][2], c[2][2];
        unpack8(ra0, a[0][0], a[0][1]); unpack8(ra1, a[1][0], a[1][1]); unpack8(rb0, c[0][0], c[0][1]); unpack8(rb1, c[1][0], c[1][1]);
        float ss0 = sq8(a[0][0], a[0][1]) + sq8(a[1][0], a[1][1]), ss1 = sq8(c[0][0], c[0][1]) + sq8(c[1][0], c[1][1]);
#pragma unroll
        for (int o = 1; o < 64; o <<= 1) { ss0 += __shfl_xor(ss0, o); ss1 += __shfl_xor(ss1, o); }
        const float rstd0 = 1.0f / sqrtf(ss0 * (1.0f / DM) + EPS), rstd1 = 1.0f / sqrtf(ss1 * (1.0f / DM) + EPS);
        float* orow = out + (size_t)i * DM + 8 * lane;
#pragma unroll
        for (int j = 0; j < 2; ++j)
#pragma unroll
            for (int q = 0; q < 2; ++q) { *(f32x4*)(orow + 512 * j + 4 * q) = a[j][q] * rstd0 * g[j][q]; *(f32x4*)(orow + DM + 512 * j + 4 * q) = c[j][q] * rstd1 * g[j][q]; }
    }
}

__device__ __forceinline__ v4u normrope8(v4u raw, const float* gain, int s, bool rope, float pos, const float (&invf)[8], float scale) {
    float v[8]; v[0] = bflo(raw.x); v[1] = bfhi(raw.x); v[2] = bflo(raw.y); v[3] = bfhi(raw.y); v[4] = bflo(raw.z); v[5] = bfhi(raw.z); v[6] = bflo(raw.w); v[7] = bfhi(raw.w);
    float ss = 0.f;
#pragma unroll
    for (int i = 0; i < 8; ++i) ss += v[i] * v[i];
    ss += __shfl_xor(ss, 1); ss += __shfl_xor(ss, 2); ss += __shfl_xor(ss, 4);
    const float rstd = 1.0f / sqrtf(ss * (1.0f / 64.0f) + EPS);
    const f32x4 g0 = *(const f32x4*)(gain + 8 * s), g1 = *(const f32x4*)(gain + 8 * s + 4);
    float y[8];
#pragma unroll
    for (int i = 0; i < 4; ++i) { y[i] = v[i] * rstd * g0[i]; y[4 + i] = v[4 + i] * rstd * g1[i]; }
    if (rope) {
#pragma unroll
        for (int i = 0; i < 8; ++i) { const float p = __shfl_xor(y[i], 2); const float ang = pos * invf[i]; const float cs = __cosf(ang), sn = __sinf(ang);
            y[i] = (s & 2) ? (y[i] * cs + p * sn) : (y[i] * cs - p * sn); }
    }
    v4u o; o.x = pk2(y[0] * scale, y[1] * scale); o.y = pk2(y[2] * scale, y[3] * scale); o.z = pk2(y[4] * scale, y[5] * scale); o.w = pk2(y[6] * scale, y[7] * scale);
    return o;
}
constexpr float QSCALE = 0.125f * 1.4426950408889634f;
__device__ __forceinline__ void normrope_phase(bf16* P, const float* kgain, int gw, int NGW, int lane) {
    const int s = lane & 7, q = lane >> 4, piece = lane & 15;
    float invf[8];
#pragma unroll
    for (int i = 0; i < 8; ++i) invf[i] = exp2f(-(float)(8 * (s & 1) + i) * (13.287712379549449f / 16.0f));
    const int rpw = (((MTOK + NGW - 1) / NGW) + 11) / 12 * 12; const int r0 = gw * rpw; int r1 = r0 + rpw; if (r1 > MTOK) r1 = MTOK;
    for (int r = r0; r < r1; r += 12) {
        v4u rk[3];
#pragma unroll
        for (int g = 0; g < 3; ++g) rk[g] = *(const v4u*)(P + (size_t)(r + 4 * g + q) * INW + 512 + 8 * piece);
#pragma unroll
        for (int g = 0; g < 3; ++g) {
            const int rr = r + 4 * g; const int b = rr / TPB, t = rr - b * TPB + q; const bool rope = t < SEQ;
            const float pos = (s < 4) ? (float)(t >> 6) : (float)(t & 63);
            *(v4u*)(P + (size_t)(rr + q) * INW + 512 + 8 * piece) = normrope8(rk[g], kgain, s, rope, pos, invf, 1.0f);
        }
    }
}

__device__ __forceinline__ void sgu_phase(const bf16* P, bf16* MIX, const bf16* Wsb  , const float* bs  , LAS unsigned char* lds, int wave, int gw, int NGW, int lane) {
    LAS unsigned short* vT = (LAS unsigned short*)(lds + wave * 17408);
    const int fr = lane & 15, fq = lane >> 4;
    for (int unit = gw; unit < (MTOK / 128) * 4; unit += NGW) {
        const int cidx = unit >> 2, g = unit & 3; const size_t row0 = (size_t)cidx * 128;
        v4u rawv[16];
#pragma unroll
        for (int it = 0; it < 16; ++it) { const int idx = it * 64 + lane, q = idx >> 3, pc = idx & 7; rawv[it] = *(const v4u*)(P + (row0 + q) * INW + 1024 + 64 * g + 8 * pc); }
#pragma unroll
        for (int it = 0; it < 16; ++it) { const int idx = it * 64 + lane, q = idx >> 3, pc = idx & 7;
            const v4u raw = rawv[it];
            LAS unsigned short* dst = vT + (8 * pc) * 136 + q;
            dst[0 * 136] = (unsigned short)(raw.x & 0xffffu); dst[1 * 136] = (unsigned short)(raw.x >> 16); dst[2 * 136] = (unsigned short)(raw.y & 0xffffu); dst[3 * 136] = (unsigned short)(raw.y >> 16);
            dst[4 * 136] = (unsigned short)(raw.z & 0xffffu); dst[5 * 136] = (unsigned short)(raw.z >> 16); dst[6 * 136] = (unsigned short)(raw.w & 0xffffu); dst[7 * 136] = (unsigned short)(raw.w >> 16); }
        LDS_WAIT(); asm volatile("" ::: "memory");
#pragma unroll 1
        for (int ph = 0; ph < 2; ++ph) {
            f32x4 acc[4][4];
#pragma unroll
            for (int pb = 0; pb < 4; ++pb)
#pragma unroll
                for (int db = 0; db < 4; ++db) acc[pb][db] = (f32x4){0.f, 0.f, 0.f, 0.f};
#pragma unroll
            for (int kq = 0; kq < 4; ++kq) {
                bf16x8 af[4], bfr[4];
#pragma unroll
                for (int db = 0; db < 4; ++db) af[db] = *(const LAS bf16x8*)(vT + (16 * db + fr) * 136 + 32 * kq + 8 * fq);
#pragma unroll
                for (int pb = 0; pb < 4; ++pb) bfr[pb] = *(const bf16x8*)(Wsb + (size_t)(g * 128 + 64 * ph + 16 * pb + fr) * 128 + 32 * kq + 8 * fq);
#pragma unroll
                for (int pb = 0; pb < 4; ++pb)
#pragma unroll
                    for (int db = 0; db < 4; ++db) acc[pb][db] = __builtin_amdgcn_mfma_f32_16x16x32_bf16(af[db], bfr[pb], acc[pb][db], 0, 0, 0);
            }
#pragma unroll
            for (int pb = 0; pb < 4; ++pb) { const int p = 64 * ph + 16 * pb + fr; const float bias = bs[g * 128 + p]; const size_t row = row0 + p;
#pragma unroll
                for (int db = 0; db < 4; ++db) { const int d = 16 * db + 4 * fq; const v2u uu = *(const v2u*)(P + row * INW + 768 + 64 * g + d);
                    v2u o; o.x = pk2(bflo(uu.x) * (acc[pb][db][0] + bias), bfhi(uu.x) * (acc[pb][db][1] + bias)); o.y = pk2(bflo(uu.y) * (acc[pb][db][2] + bias), bfhi(uu.y) * (acc[pb][db][3] + bias));
                    *(v2u*)(MIX + row * DM + 512 + 64 * g + d) = o; } }
        }
        LDS_WAIT(); asm volatile("" ::: "memory");
    }
}

__device__ __forceinline__ void pool_phase(const bf16* P, bf16* MIX, const bf16* WpT  , const float* pscale  , LAS unsigned char* lds, int wave, int gw, int NGW, int lane) {
    const int fr = lane & 15, fq = lane >> 4;
    LAS unsigned char* img = lds + wave * 16896;
    for (int tb = gw; tb < MTOK / 16; tb += NGW) {
        const int r0 = tb * 16; const int b = r0 / TPB, t0 = r0 - b * TPB; const int tt0 = (t0 < SEQ) ? t0 : t0 - SEQ, L = (t0 < SEQ) ? SEQ : CTXL;
        const bf16* seg = P + (size_t)(r0 - tt0) * INW + 1280;
#pragma unroll
        for (int it = 0; it < 16; ++it) { const int idx = it * 64 + lane, row = idx >> 5, pc = idx & 31;
            int tp = tt0 - 8 + row; tp = tp < 0 ? 0 : (tp > L - 1 ? L - 1 : tp);
            *(LAS v4u*)(img + row * 528 + pc * 16) = *(const v4u*)(seg + (size_t)tp * INW + 8 * pc); }
        LDS_WAIT(); asm volatile("" ::: "memory");
        const int tt = tt0 + fr; const int r = r0 + fr;
#pragma unroll 1
        for (int gi = 0; gi < 4; ++gi) {
            const int w = 2 << gi, left = w >> 1, right = w - 1 - left;
            int lo = tt - left; if (lo < 0) lo = 0; int hi = tt + right; if (hi > L - 1) hi = L - 1;
            const float rc = 1.0f / (float)(hi - lo + 1);
            bf16x8 yf[2];
#pragma unroll
            for (int ks = 0; ks < 2; ++ks) {
                const LAS unsigned char* src = img + (64 * gi + 32 * ks + 8 * fq) * 2;
                float sum[8];
#pragma unroll
                for (int i = 0; i < 8; ++i) sum[i] = 0.f;
                for (int tp = lo; tp <= hi; ++tp) { const v4u raw = *(const LAS v4u*)(src + (tp - tt0 + 8) * 528);
                    sum[0] += bflo(raw.x); sum[1] += bfhi(raw.x); sum[2] += bflo(raw.y); sum[3] += bfhi(raw.y); sum[4] += bflo(raw.z); sum[5] += bfhi(raw.z); sum[6] += bflo(raw.w); sum[7] += bfhi(raw.w); }
                const v4u own = *(const LAS v4u*)(src + (fr + 8) * 528);
                v4u pkd; pkd.x = pk2(sum[0] * rc - bflo(own.x), sum[1] * rc - bfhi(own.x)); pkd.y = pk2(sum[2] * rc - bflo(own.y), sum[3] * rc - bfhi(own.y));
                pkd.z = pk2(sum[4] * rc - bflo(own.z), sum[5] * rc - bfhi(own.z)); pkd.w = pk2(sum[6] * rc - bflo(own.w), sum[7] * rc - bfhi(own.w));
                yf[ks] = __builtin_bit_cast(bf16x8, pkd);
            }
#pragma unroll
            for (int eb = 0; eb < 4; ++eb) {
                f32x4 acc = (f32x4){0.f, 0.f, 0.f, 0.f};
#pragma unroll
                for (int ks = 0; ks < 2; ++ks) { const bf16x8 af = *(const bf16x8*)(WpT + (size_t)(gi * 64 + 16 * eb + fr) * 64 + 32 * ks + 8 * fq); acc = __builtin_amdgcn_mfma_f32_16x16x32_bf16(af, yf[ks], acc, 0, 0, 0); }
                const int e = 16 * eb + 4 * fq; const f32x4 psc = *(const f32x4*)(pscale + 64 * gi + e);
                v2u o; o.x = pk2(acc[0] * psc[0], acc[1] * psc[1]); o.y = pk2(acc[2] * psc[2], acc[3] * psc[3]);
                *(v2u*)(MIX + (size_t)r * DM + 768 + 64 * gi + e) = o;
            }
        }
        LDS_WAIT(); asm volatile("" ::: "memory");
    }
}

__device__ __forceinline__ void fixup_phase(bf16* A, const float* SB, const float* cw, int skip_ctx, int gw, int NGW, int lane) {
    for (int item = gw; item < NTILE * 8; item += NGW) {
        const int pm = item >> 3, e = item & 7; const int b = pm / 9, j = pm - 9 * b;
        if (skip_ctx && j == 8) continue;
        int npm = -1, ne = 0;
        if ((e & 1) == 0) { if (e > 0) { npm = pm; ne = e - 1; } else if (j >= 1 && j <= 7) { npm = pm - 1; ne = 7; } }
        else { if (e < 7) { npm = pm; ne = e + 1; } else if (j <= 6) { npm = pm + 1; ne = 0; } }
        if (npm < 0) continue;
        const float* own = SB + (size_t)(pm * 8 + e) * 4 * 2816; const float* nbr = SB + (size_t)(npm * 8 + ne) * 4 * 2816;
        const float* wt = cw + ((e & 1) ? 2 * FF2 : 0);
        bf16* arow = A + (size_t)(pm * 256 + 64 * (e >> 1) + ((e & 1) ? 63 : 0)) * FF;
#pragma unroll 4
        for (int i = lane; i < FF / 4; i += 64) { const int jj = 4 * i;
            const f32x4 zg = *(const f32x4*)(own + 2 * 2816 + jj) + *(const f32x4*)(wt + jj) * *(const f32x4*)(nbr + jj);
            const f32x4 zv = *(const f32x4*)(own + 3 * 2816 + jj) + *(const f32x4*)(wt + FF + jj) * *(const f32x4*)(nbr + 2816 + jj);
            v2u o; o.x = pk2(pg8::silu_f(zg[0]) * zv[0], pg8::silu_f(zg[1]) * zv[1]); o.y = pk2(pg8::silu_f(zg[2]) * zv[2], pg8::silu_f(zg[3]) * zv[3]);
            *(v2u*)(arow + jj) = o; }
    }
}
#ifndef REP_LIGHT
#define REP_LIGHT 1
#endif
#ifndef REP_ATTN
#define REP_ATTN 1
#endif
#ifndef REP_SYNC
#define REP_SYNC 1
#endif
__global__ void __launch_bounds__(512, 2) mk_fwd(Args args) {
    extern __shared__ __attribute__((aligned(16))) unsigned char lds[];
    cg::grid_group grid = cg::this_grid();
    LAS unsigned char* l3 = (LAS unsigned char*)lds;
    int tid = pg8::opaque_tid(), lane = tid & 63, wave = __builtin_amdgcn_readfirstlane(tid >> 6);
    const int G = gridDim.x, bx = blockIdx.x;
    const int vcu = (G % 8 == 0) ? (bx % 8) * (G / 8) + bx / 8 : bx;
    int gw = vcu * 8 + wave; const int NGW = G * 8;
    unsigned char* ws = args.ws;
#define RELAUNDER() do { ws = args.ws; asm volatile("" : "+s"(ws)); tid = pg8::opaque_tid(); lane = tid & 63; wave = __builtin_amdgcn_readfirstlane(tid >> 6); gw = vcu * 8 + wave; } while (0)
    float* PRM = (float*)(ws + WS_PRM);
#define GSYNC() do { for (int rs_ = 0; rs_ < REP_SYNC; ++rs_) xcd_barrier(xbar); RELAUNDER(); } while (0)
#define MOD ((float*)(ws + WS_MOD))
#define WSB ((bf16*)(ws + WS_WSB))
#define WPT ((bf16*)(ws + WS_WPT))
#define SB ((float*)(ws + WS_SB))
#define X ((bf16*)(ws + WS_X))
#define H ((bf16*)(ws + WS_H))
#define P ((bf16*)(ws + WS_P))
#define MIX ((bf16*)(ws + WS_MIX))
#define A ((bf16*)(ws + WS_A))
#define x_in (args.in[0])
#define ctx_in (args.in[2])
#define PRML ((const float*)(ws + WS_PRM) + (size_t)l * PRM_L)

    if (bx == 0) for (int i = tid; i < XCD_BAR_WORDS; i += 512) ((unsigned*)(ws + WS_BAR))[i] = 0u;
    if (tid < 2) ((volatile LAS unsigned*)(l3 + LDS_BYTES - 64))[tid] = 0u;
    __syncthreads();
#if !defined(ONLY) || ONLY==1
    mod_phase(args, l3, tid);
#endif

    {
        LAS float* scr = (LAS float*)(l3 + wave * 16384);
        constexpr int I_IN = 16 * 48, I_OUT = 16 * 32, I_UP = 16 * 176, I_DN = 44 * 32, I_L = I_IN + I_OUT + I_UP + I_DN;
        for (int it = gw; it < NLAYER * I_L; it += NGW) {
            const int l = it / I_L; int r = it - l * I_L;
            if (r < I_IN) { p0_transpose_item(args.in[7] + (size_t)l * DM * INW, DM, INW, (bf16*)(ws + WS_WIN) + (size_t)l * INW * DM, false, scr, r, lane); continue; } r -= I_IN;
            if (r < I_OUT) { p0_transpose_item(args.in[14] + (size_t)l * DM * DM, DM, DM, (bf16*)(ws + WS_WOUT) + (size_t)l * DM * DM, false, scr, r, lane); continue; } r -= I_OUT;
            if (r < I_UP) { p0_transpose_item(args.in[16] + (size_t)l * DM * FF2, DM, FF2, (bf16*)(ws + WS_WUP) + (size_t)l * FF2 * DM, true, scr, r, lane); continue; } r -= I_UP;
            p0_transpose_item(args.in[19] + (size_t)l * FF * DM, FF, DM, (bf16*)(ws + WS_WDN) + (size_t)l * DM * FF, false, scr, r, lane);
        }
        const int gt = gw * 64 + lane, NGT = NGW * 64;
        for (int l = 0; l < NLAYER; ++l) { float* pl = PRM + (size_t)l * PRM_L;
            for (int i = gt; i < 1024; i += NGT) { pl[PRM_N1G + i] = args.in[6][l * 1024 + i]; pl[PRM_N2G + i] = args.in[15][l * 1024 + i]; }
            for (int i = gt; i < 64; i += NGT) { pl[PRM_QG + i] = args.in[8][l * 64 + i]; pl[PRM_KG + i] = args.in[9][l * 64 + i]; }
            for (int i = gt; i < 512; i += NGT) pl[PRM_BS + i] = args.in[11][l * 512 + i];
            for (int i = gt; i < 256; i += NGT) pl[PRM_PSC + i] = args.in[13][l * 256 + i];
            for (int i = gt; i < 3 * FF2; i += NGT) pl[PRM_CW + i] = args.in[17][(size_t)l * 3 * FF2 + i];
            for (int i = gt; i < FF2; i += NGT) pl[PRM_CB + i] = args.in[18][(size_t)l * FF2 + i]; }
        for (int i = gt; i < 1024; i += NGT) PRM[NLAYER * PRM_L + i] = args.in[20][i];
        for (int i = gt; i < NLAYER * 4 * 128 * 128; i += NGT) WSB[i] = (bf16)(pk2(args.in[10][i], 0.f) & 0xffffu);
        for (int i = gt; i < NLAYER * 4 * 64 * 64; i += NGT) { const int d = i & 63, e = (i >> 6) & 63, lg = i >> 12; WPT[i] = (bf16)(pk2(args.in[12][(size_t)lg * 4096 + d * 64 + e], 0.f) & 0xffffu); }
    }
    grid.sync(); RELAUNDER();
    XcdBarrier xbar = xcd_barrier_post((unsigned*)(ws + WS_BAR), (volatile LAS unsigned*)(l3 + LDS_BYTES - 64));

    for (int l = 0; l < NLAYER; ++l) {
        const int last = (l == NLAYER - 1);
#define mod (MOD + (size_t)l * 33 * MODW)
#define Win_t ((const bf16*)(ws + WS_WIN) + (size_t)l * INW * DM)
#define Wout_t ((const bf16*)(ws + WS_WOUT) + (size_t)l * DM * DM)
#define Wup_t ((const bf16*)(ws + WS_WUP) + (size_t)l * FF2 * DM)
#define Wdn_t ((const bf16*)(ws + WS_WDN) + (size_t)l * DM * FF)
#if !defined(ONLY) || ONLY==2
        for (int rep_ = 0; rep_ < REP_LIGHT; ++rep_)
        if (l == 0) norm_phase(x_in, ctx_in, nullptr, 1, PRML + PRM_N1G, mod, 0, 1024, H, 0, gw, NGW, lane);
        else norm_phase_b(X, PRML + PRM_N1G, mod, 0, 1024, H, 0, gw, NGW, lane);
#endif

        GSYNC();
#if !defined(ONLY) || ONLY==3
        { pg8::Gemm g{H, Win_t, MTOK, INW, DM}; pg8::TileOrder S; S.init(NTILE, INW, G, bx, 0);
          pg8::EpiBf16<0> E{P, INW, nullptr, 0, 0, 1.f};
          pg8::gemm_phase<pg8::EpiBf16<0>, pg8::TileOrder, true, true>(l3, g, S, E); }
#endif

        GSYNC();
#if !defined(ONLY) || ONLY==4
        normrope_phase(P, PRML + PRM_KG, gw, NGW, lane);
#endif

#if !defined(ONLY) || ONLY==5
        for (int rep_ = 0; rep_ < REP_LIGHT; ++rep_) {
        sgu_phase(P, MIX, WSB + (size_t)l * 4 * 128 * 128, PRML + PRM_BS, l3, wave, gw, NGW, lane);
#endif

#if !defined(ONLY) || ONLY==6
        pool_phase(P, MIX, WPT + (size_t)l * 4 * 64 * 64, PRML + PRM_PSC, l3, wave, gw, NGW, lane); }
#endif

        GSYNC();
        {
#if !defined(ONLY) || ONLY==7
            for (int rep_ = 0; rep_ < REP_ATTN; ++rep_)
            for (int bh = vcu; bh < NB * 8; bh += G) {
                const int b = bh >> 3, h = bh & 7;
                const attn_body::bf16* Pb = (const attn_body::bf16*)P + (size_t)b * TPB * INW;
                attn_body::bf16* Ob = (attn_body::bf16*)MIX + (size_t)b * TPB * DM + h * 64;
                const attn_body::bf16* Kb = Pb + 512 + (h >> 2) * 64; const attn_body::bf16* Vb = Pb + 640 + (h >> 2) * 64;
                const int nu = last ? 8 : 9;
                for (int qb = 0; qb < nu; ++qb) {
                    const attn_body::bf16* Qu = Pb + (size_t)(qb * 256) * INW + h * 64;
                    if (qb < 8) attn_body::attn_unit<8>(Qu, Kb, Vb, Ob + (size_t)(qb * 256) * DM, (SEQ + CTXL) / 64, (char*)lds, PRML + PRM_QG, qb * 256);
                    else attn_body::attn_unit<8>(Qu, Kb + (size_t)SEQ * INW, Vb + (size_t)SEQ * INW, Ob + (size_t)(qb * 256) * DM, CTXL / 64, (char*)lds, PRML + PRM_QG, -1);
                }
            }
#endif

        }
        GSYNC();
#if !defined(ONLY) || ONLY==8
        { pg8::Gemm g{MIX, Wout_t, MTOK, DM, DM}; pg8::TileOrder S; S.init(last ? NB * 8 : NTILE, DM, G, bx, last);
          pg8::EpiRes E{x_in, ctx_in, X, mod + 2048, l == 0};
          pg8::gemm_phase<pg8::EpiRes, pg8::TileOrder, true, true>(l3, g, S, E); }
#endif

        GSYNC();
        for (int rep_ = 0; rep_ < REP_LIGHT; ++rep_)
        norm_phase_b(X, PRML + PRM_N2G, mod, 3072, 4096, H, last, gw, NGW, lane);
        GSYNC();
#if !defined(ONLY) || ONLY==9
        { pg8::Gemm g{H, Wup_t, MTOK, FF2, DM}; pg8::TileOrder S; S.init(last ? NB * 8 : NTILE, FF2, G, bx, last);
          pg8::EpiUpGate E{A, SB, PRML + PRM_CW, PRML + PRM_CB, (LAS float*)(l3 + 131072 + 4096)};
          pg8::gemm_phase<pg8::EpiUpGate, pg8::TileOrder, true, true>(l3, g, S, E); }
#endif

        GSYNC();
#if !defined(ONLY) || ONLY==10
        for (int rep_ = 0; rep_ < REP_LIGHT; ++rep_)
        fixup_phase(A, SB, PRML + PRM_CW, last, gw, NGW, lane);
#endif

        GSYNC();
#if !defined(ONLY) || ONLY==11
        { pg8::Gemm g{A, Wdn_t, MTOK, DM, FF}; pg8::TileOrder S; S.init(last ? NB * 8 : NTILE, DM, G, bx, last);
          pg8::EpiRes E{x_in, ctx_in, X, mod + 5120, 0};
          pg8::gemm_phase<pg8::EpiRes, pg8::TileOrder, true, true>(l3, g, S, E); }
#endif

        GSYNC();
    }
    for (int rep_ = 0; rep_ < REP_LIGHT; ++rep_)
    final_norm_phase(X, (const float*)(ws + WS_PRM) + NLAYER * PRM_L, args.out, gw, NGW, lane);
}

extern "C" void kernel_launch(void* const* d_in, const int* in_sizes, int n_in, void* d_out, int out_size, void* d_ws, size_t ws_size, hipStream_t stream) {
    static int grid = 0;
    if (grid == 0) {
        if (n_in != 21 || in_sizes[0] != NB * SEQ * DM || out_size != NB * SEQ * DM || ws_size < WS_END) { fprintf(stderr, "kernel_launch: unexpected shapes (n_in %d, in0 %d, out %d, ws %zu); nothing launched\n", n_in, n_in > 0 ? in_sizes[0] : -1, out_size, ws_size); grid = -1; return; }
        int dev = 0, cus = 0, per_cu = 0;
        if (hipGetDevice(&dev) != hipSuccess || hipDeviceGetAttribute(&cus, hipDeviceAttributeMultiprocessorCount, dev) != hipSuccess) { grid = -1; return; }
        if (hipFuncSetAttribute((const void*)mk_fwd, hipFuncAttributeMaxDynamicSharedMemorySize, LDS_BYTES) != hipSuccess) { fprintf(stderr, "kernel_launch: hipFuncSetAttribute failed\n"); grid = -1; return; }
        if (hipOccupancyMaxActiveBlocksPerMultiprocessor(&per_cu, (const void*)mk_fwd, 512, LDS_BYTES) != hipSuccess || per_cu < 1) { fprintf(stderr, "kernel_launch: occupancy query says %d\n", per_cu); per_cu = 1; }
        (void)hipGetLastError();
        grid = cus * 1;
    }
    if (grid < 0) return;
    Args a{};
    for (int i = 0; i < 21; ++i) a.in[i] = (const float*)d_in[i];
    a.out = (float*)d_out; a.ws = (unsigned char*)d_ws;
    void* kargs[] = {&a};
    hipError_t e = hipLaunchCooperativeKernel((const void*)mk_fwd, dim3(grid), dim3(512), kargs, LDS_BYTES, stream);
    if (e != hipSuccess) fprintf(stderr, "cooperative launch failed: %s (grid %d)\n", hipGetErrorString(e), grid);
}
```
